# Optimizing an MI355X kernel written in HIP

```python
import math
import jax, jax.numpy as jnp
from jax import lax
import numpy as np

D_MODEL = 2048
BATCH = 1
SEQ = 8192
DEPTH = 4

N_A_LAYERS = DEPTH // 2
N_B_LAYERS = DEPTH - N_A_LAYERS

MLA_HEADS = 16
Q_LORA = 512
KV_LORA = 512
QK_NOPE = 128
QK_ROPE = 64
V_HEAD = 128
ROPE_THETA = 10000.0
ATTN_Q_BLOCK = 128

MOBA_HEADS = 16
MOBA_HEAD = D_MODEL // MOBA_HEADS
MOBA_BLOCK = 256
MOBA_TOPK = 3
MOBA_Q_CHUNK = 32

REL_BUCKETS = 32
REL_MAX_DIST = 128

D_FF = 5632
CONV_WIDTH = 3

EPS = 1e-6
NEG = -1e30

kernel_name = 'hybrid_mla_moba_yoco'


def rms_norm(x, g):
    xf = x.astype(jnp.float32)
    y = xf * lax.rsqrt(jnp.mean(xf * xf, axis=-1, keepdims=True) + EPS)
    return (y * g.astype(jnp.float32)).astype(x.dtype)


def rope(x, pos):
    half = x.shape[-1] // 2
    inv = ROPE_THETA ** (-jnp.arange(half, dtype=jnp.float32) / half)
    ang = (pos.astype(jnp.float32)[..., None] * inv)[:, :, None, :]
    cos, sin = jnp.cos(ang), jnp.sin(ang)
    x1 = x[..., :half].astype(jnp.float32)
    x2 = x[..., half:].astype(jnp.float32)
    return jnp.concatenate([x1 * cos - x2 * sin, x1 * sin + x2 * cos], axis=-1).astype(x.dtype)


def rel_bucket(dist):
    n = jnp.maximum(dist, 0)
    max_exact = REL_BUCKETS // 2
    nf = jnp.maximum(n, 1).astype(jnp.float32)
    large = max_exact + (jnp.log(nf / max_exact) / math.log(REL_MAX_DIST / max_exact)
                         * (REL_BUCKETS - max_exact)).astype(jnp.int32)
    large = jnp.minimum(large, REL_BUCKETS - 1)
    return jnp.where(n < max_exact, n, large)


def causal_dense_attention(q, k, v, scale):
    B, S, H, Dq = q.shape
    nq = S // ATTN_Q_BLOCK
    qb = q.reshape(B, nq, ATTN_Q_BLOCK, H, Dq).transpose(1, 0, 2, 3, 4)
    k_idx = jnp.arange(S)

    def one_block(args):
        i, qblk = args
        logits = jnp.einsum('bqhd,bkhd->bhqk', qblk, k).astype(jnp.float32) * scale
        q_idx = i * ATTN_Q_BLOCK + jnp.arange(ATTN_Q_BLOCK)
        mask = k_idx[None, :] <= q_idx[:, None]
        logits = jnp.where(mask[None, None], logits, NEG)
        p = jax.nn.softmax(logits, axis=-1).astype(v.dtype)
        return jnp.einsum('bhqk,bkhd->bqhd', p, v)

    out = lax.map(one_block, (jnp.arange(nq), qb))
    return out.transpose(1, 0, 2, 3, 4).reshape(B, S, H, v.shape[-1])


def mla_mixer(xn, pos, w_in, q_norm_g, w_q_up, kv_norm_g, w_kv_up, w_o):
    B, S, _ = xn.shape
    h = xn @ w_in
    c_q, c_kv, k_r = jnp.split(h, [Q_LORA, Q_LORA + KV_LORA], axis=-1)
    q = (rms_norm(c_q, q_norm_g) @ w_q_up).reshape(B, S, MLA_HEADS, QK_NOPE + QK_ROPE)
    q = jnp.concatenate([q[..., :QK_NOPE], rope(q[..., QK_NOPE:], pos)], axis=-1)
    kv = (rms_norm(c_kv, kv_norm_g) @ w_kv_up).reshape(B, S, MLA_HEADS, QK_NOPE + V_HEAD)
    k_nope, v = kv[..., :QK_NOPE], kv[..., QK_NOPE:]
    k_r = rope(k_r[:, :, None, :], pos)
    k = jnp.concatenate([k_nope, jnp.broadcast_to(k_r, (B, S, MLA_HEADS, QK_ROPE))], axis=-1)
    o = causal_dense_attention(q, k, v, (QK_NOPE + QK_ROPE) ** -0.5)
    return o.reshape(B, S, MLA_HEADS * V_HEAD) @ w_o


def shared_moba_kv(h, pos, kv_norm_g, w_kv):
    B, S, _ = h.shape
    kv = rms_norm(h, kv_norm_g) @ w_kv
    k, v = jnp.split(kv, 2, axis=-1)
    nb = -(-S // MOBA_BLOCK)
    pad = nb * MOBA_BLOCK - S
    k = jnp.pad(k, ((0, 0), (0, pad), (0, 0))).reshape(B, nb, MOBA_BLOCK, MOBA_HEADS, MOBA_HEAD)
    v = jnp.pad(v, ((0, 0), (0, pad), (0, 0))).reshape(B, nb, MOBA_BLOCK, MOBA_HEADS, MOBA_HEAD)
    k_mean = jnp.mean(k.astype(jnp.float32), axis=2).astype(k.dtype)
    pos_kb = jnp.pad(pos, ((0, 0), (0, pad))).reshape(B, nb, MOBA_BLOCK)
    return k, v, k_mean, pos_kb


def moba_attention_seq(q, kb, vb, kmean, pos_q, pos_kb, bias_hb):
    S, H, Dk = q.shape
    NB = kb.shape[0]
    topk = min(MOBA_TOPK, NB)
    scale = Dk ** -0.5
    nchunk = S // MOBA_Q_CHUNK
    qc = q.reshape(nchunk, MOBA_Q_CHUNK, H, Dk)
    pc = pos_q.reshape(nchunk, MOBA_Q_CHUNK)
    kbT = kb.transpose(2, 0, 1, 3)
    vbT = vb.transpose(2, 0, 1, 3)
    head_ix = jnp.arange(H)
    blk_ix = jnp.arange(NB)

    def one_chunk(args):
        c, qq, pq = args
        t = c * MOBA_Q_CHUNK + jnp.arange(MOBA_Q_CHUNK)
        own = (c * MOBA_Q_CHUNK) // MOBA_BLOCK
        gate = jnp.einsum('qhd,nhd->qhn', qq, kmean).astype(jnp.float32)
        gate = jnp.where((blk_ix < own)[None, None, :], gate, -jnp.inf)
        _, sel = lax.top_k(gate, topk)
        valid = sel < own
        k_sel = kbT[head_ix[None, :, None], sel]
        v_sel = vbT[head_ix[None, :, None], sel]
        p_sel = pos_kb[sel]
        s_sel = jnp.einsum('qhd,qhnld->qhnl', qq, k_sel).astype(jnp.float32) * scale
        s_sel = s_sel + bias_hb[head_ix[None, :, None, None], rel_bucket(pq[:, None, None, None] - p_sel)]
        s_sel = jnp.where(valid[..., None], s_sel, NEG)
        k_own = lax.dynamic_index_in_dim(kb, own, 0, keepdims=False)
        v_own = lax.dynamic_index_in_dim(vb, own, 0, keepdims=False)
        p_own = lax.dynamic_index_in_dim(pos_kb, own, 0, keepdims=False)
        s_own = jnp.einsum('qhd,lhd->qhl', qq, k_own).astype(jnp.float32) * scale
        s_own = s_own + bias_hb[head_ix[None, :, None], rel_bucket(pq[:, None, None] - p_own[None, None, :])]
        causal = (own * MOBA_BLOCK + jnp.arange(MOBA_BLOCK))[None, :] <= t[:, None]
        s_own = jnp.where(causal[:, None, :], s_own, NEG)
        logits = jnp.concatenate([s_sel.reshape(MOBA_Q_CHUNK, H, topk * MOBA_BLOCK), s_own], axis=-1)
        p = jax.nn.softmax(logits, axis=-1).astype(vb.dtype)
        p_s = p[..., :topk * MOBA_BLOCK].reshape(MOBA_Q_CHUNK, H, topk, MOBA_BLOCK)
        p_o = p[..., topk * MOBA_BLOCK:]
        return (jnp.einsum('qhnl,qhnld->qhd', p_s, v_sel)
                + jnp.einsum('qhl,lhd->qhd', p_o, v_own))

    out = lax.map(one_chunk, (jnp.arange(nchunk), qc, pc))
    return out.reshape(S, H, vb.shape[-1])


def moba_mixer(xn, pos, w_q, w_o, rel_bias, kb, vb, kmean, pos_kb):
    B, S, _ = xn.shape
    q = (xn @ w_q).reshape(B, S, MOBA_HEADS, MOBA_HEAD)
    o = jax.vmap(moba_attention_seq, in_axes=(0, 0, 0, 0, 0, 0, None))(
        q, kb, vb, kmean, pos, pos_kb, rel_bias.T)
    return o.reshape(B, S, MOBA_HEADS * MOBA_HEAD) @ w_o


def conv_glu_ffn(xn, w_in, conv_w, conv_b, w_out):
    S = xn.shape[1]
    h = xn @ w_in
    hp = jnp.pad(h, ((0, 0), (CONV_WIDTH - 1, 0), (0, 0)))
    h = sum(hp[:, j:j + S] * conv_w[j] for j in range(CONV_WIDTH)) + conv_b
    gate, up = jnp.split(h, 2, axis=-1)
    return (jax.nn.gelu(gate, approximate=True) * up) @ w_out


def setup_inputs(seed: int = 0) -> dict:
    key = jax.random.key(seed)
    ks = jax.random.split(key, 20)
    f32 = jnp.float32

    def w(k, shape, fan_in):
        return jax.random.normal(k, shape, f32) * (fan_in ** -0.5)

    def gain(k, shape):
        return 1.0 + 0.02 * jax.random.normal(k, shape, f32)

    x = jax.random.normal(ks[0], (BATCH, SEQ, D_MODEL), f32)
    offs = jax.random.randint(ks[1], (BATCH, 1), 0, 1024, dtype=jnp.int32)
    positions = jnp.arange(SEQ, dtype=jnp.int32)[None, :] + offs
    return {
        'x': x,
        'positions': positions,
        'norm_gains': gain(ks[2], (DEPTH, 4, D_MODEL)),
        'a_w_in': w(ks[3], (N_A_LAYERS, D_MODEL, Q_LORA + KV_LORA + QK_ROPE), D_MODEL),
        'a_q_norm': gain(ks[4], (N_A_LAYERS, Q_LORA)),
        'a_w_q_up': w(ks[5], (N_A_LAYERS, Q_LORA, MLA_HEADS * (QK_NOPE + QK_ROPE)), Q_LORA),
        'a_kv_norm': gain(ks[6], (N_A_LAYERS, KV_LORA)),
        'a_w_kv_up': w(ks[7], (N_A_LAYERS, KV_LORA, MLA_HEADS * (QK_NOPE + V_HEAD)), KV_LORA),
        'a_w_o': w(ks[8], (N_A_LAYERS, MLA_HEADS * V_HEAD, D_MODEL), MLA_HEADS * V_HEAD),
        'b_kv_norm': gain(ks[9], (D_MODEL,)),
        'b_w_kv': w(ks[10], (D_MODEL, 2 * MOBA_HEADS * MOBA_HEAD), D_MODEL),
        'b_w_q': w(ks[11], (N_B_LAYERS, D_MODEL, MOBA_HEADS * MOBA_HEAD), D_MODEL),
        'b_w_o': w(ks[12], (N_B_LAYERS, MOBA_HEADS * MOBA_HEAD, D_MODEL), MOBA_HEADS * MOBA_HEAD),
        'rel_bias': 0.1 * jax.random.normal(ks[13], (REL_BUCKETS, MOBA_HEADS), f32),
        'ffn_w_in': w(ks[14], (DEPTH, D_MODEL, 2 * D_FF), D_MODEL),
        'ffn_conv_w': w(ks[15], (DEPTH, CONV_WIDTH, 2 * D_FF), CONV_WIDTH),
        'ffn_conv_b': 0.02 * jax.random.normal(ks[16], (DEPTH, 2 * D_FF), f32),
        'ffn_w_out': w(ks[17], (DEPTH, D_FF, D_MODEL), D_FF),
    }


def reference(x, positions, norm_gains, a_w_in, a_q_norm, a_w_q_up, a_kv_norm, a_w_kv_up, a_w_o,
              b_kv_norm, b_w_kv, b_w_q, b_w_o, rel_bias, ffn_w_in, ffn_conv_w, ffn_conv_b, ffn_w_out):
    h = x
    shared = None
    for layer in range(DEPTH):
        g = norm_gains[layer]
        if layer == N_A_LAYERS:
            shared = shared_moba_kv(h, positions, b_kv_norm, b_w_kv)
        xn = rms_norm(h, g[0])
        if layer < N_A_LAYERS:
            mix = mla_mixer(xn, positions, a_w_in[layer], a_q_norm[layer], a_w_q_up[layer],
                            a_kv_norm[layer], a_w_kv_up[layer], a_w_o[layer])
        else:
            j = layer - N_A_LAYERS
            kb, vb, kmean, pos_kb = shared
            mix = moba_mixer(xn, positions, b_w_q[j], b_w_o[j], rel_bias, kb, vb, kmean, pos_kb)
        h = h + rms_norm(mix, g[1])
        f = conv_glu_ffn(rms_norm(h, g[2]), ffn_w_in[layer], ffn_conv_w[layer],
                         ffn_conv_b[layer], ffn_w_out[layer])
        h = h + rms_norm(f, g[3])
    return h
```

```cpp
#include <hip/hip_runtime.h>
#include <cstdio>
#include <cstdint>

#ifndef MK_ONE_LAUNCH
#define MK_ONE_LAUNCH 0
#endif

#ifndef SITE_MASK
#define SITE_MASK 0xFFFF
#endif
#define SITE(n) (((SITE_MASK) >> (n)) & 1)
#define LAS __attribute__((address_space(3)))
#define GAS __attribute__((address_space(1)))
typedef unsigned short bf16_t;
typedef short bf16x8 __attribute__((ext_vector_type(8)));
typedef short s16x4 __attribute__((ext_vector_type(4)));
typedef float f32x2 __attribute__((ext_vector_type(2)));
typedef float f32x4 __attribute__((ext_vector_type(4)));
typedef float f32x16 __attribute__((ext_vector_type(16)));
typedef unsigned u32x2 __attribute__((ext_vector_type(2)));
typedef unsigned u32x4 __attribute__((ext_vector_type(4)));
typedef int i32x4 __attribute__((ext_vector_type(4)));
typedef GAS unsigned gu32;

constexpr int S = 8192, D = 2048, NH = 16, FF = 5632, FF2 = 11264;
constexpr int QL = 512, KVL = 512, DQK = 192;
constexpr int NIN = 1088, NINP = 1280;
constexpr int NQUP = NH * DQK, NKVUP = NH * 256;
constexpr int NLAYER = 4;
constexpr float EPS = 1e-6f;
constexpr int NPHASE = 1 + NLAYER * 9;

constexpr size_t MiB = 1u << 20;
constexpr size_t WS_CTL = 0, CTL_ZERO_BYTES = 1 * MiB;
constexpr size_t WS_WIN = 2 * MiB;
constexpr size_t WS_WUPG = 12 * MiB;
constexpr size_t WS_WO = 26 * MiB;
constexpr size_t WS_WKVQ = 58 * MiB;
constexpr size_t WS_WQ1 = 82 * MiB;
constexpr size_t WS_WUP = 90 * MiB;
constexpr size_t WS_WDN = 266 * MiB;
constexpr size_t WS_HB = 354 * MiB;
constexpr size_t WS_RSH = 386 * MiB;
constexpr size_t WS_CQ = 387 * MiB;
constexpr size_t WS_CKV = 395 * MiB;
constexpr size_t WS_KROPE = 403 * MiB;
constexpr size_t WS_SSQ = 404 * MiB;
constexpr size_t WS_Q = 405 * MiB;
constexpr size_t WS_KN = 453 * MiB;
constexpr size_t WS_V = 485 * MiB;
constexpr size_t WS_KB = 517 * MiB;
constexpr size_t WS_VB = 549 * MiB;
constexpr size_t WS_KMEAN = 581 * MiB;
constexpr size_t WS_SEL = 582 * MiB;
constexpr size_t WS_O = 583 * MiB;
constexpr size_t WS_MIX = 615 * MiB;
constexpr size_t WS_SSM = 647 * MiB;
constexpr size_t WS_U = 648 * MiB;
constexpr size_t WS_ACT = 824 * MiB;
constexpr size_t WS_RCOS = 912 * MiB;
constexpr size_t WS_RSIN = 913 * MiB;
constexpr size_t WS_END = 914 * MiB;

constexpr int CW_BAR = 4096;

constexpr int RING_BYTES = 131072;
constexpr int LDSCTL_OFF = RING_BYTES, MISC_OFF = LDSCTL_OFF + 320;
constexpr int LDS_BYTES = 147456;
constexpr int NWAVES = 8;

#define LDS_WAIT() asm volatile("s_waitcnt lgkmcnt(0)" ::: "memory")
#define VM_WAIT() asm volatile("s_waitcnt vmcnt(0)" ::: "memory")
#define SBAR() __builtin_amdgcn_sched_barrier(0)

__device__ __forceinline__ int opaque_tid() { int t = threadIdx.x; asm volatile("" : "+v"(t)); return t; }
__device__ __forceinline__ unsigned cvt_pk_bf16(float lo, float hi) { unsigned r; asm volatile("v_cvt_pk_bf16_f32 %0, %1, %2" : "=v"(r) : "v"(lo), "v"(hi)); return r; }
__device__ __forceinline__ float bf2f(unsigned short b) { return __uint_as_float(((unsigned)b) << 16); }
__device__ __forceinline__ float bflo(unsigned w) { return __uint_as_float(w << 16); }
__device__ __forceinline__ float bfhi(unsigned w) { return __uint_as_float(w & 0xffff0000u); }
__device__ __forceinline__ float wave_sum(float v) {
#pragma unroll
    for (int o = 1; o < 64; o <<= 1) v += __shfl_xor(v, o);
    return v;
}

namespace pg8 {
constexpr int BM = 256, BK = 64, HALF = 128, HTB = HALF * BK * 2, STAGE_BYTES = 8 * HTB, NXCD = 8, WGM = 8;
__host__ __device__ __forceinline__ int lds_byte(int r, int c) { const int st = (r >> 4) * 2 + (c >> 5), rr = r & 15, cc = c & 31, ob = rr * 64 + cc * 2; return st * 1024 + (ob ^ (((ob >> 9) & 1) << 5)); }
__host__ __device__ __forceinline__ void stage_rc(int b, int& R, int& C) { const int st = b / 1024, sb = b % 1024, swz = sb ^ (((sb >> 9) & 1) << 5); R = (st >> 1) * 16 + swz / 64; C = (st & 1) * 32 + (swz % 64) / 2; }
__host__ __device__ __forceinline__ int perm32(int rho) { const int n = rho >> 4, i = rho & 15; return 8 * (i >> 2) + 4 * n + (i & 3); }

struct Unit { int pm, pn, gi; };

struct Sched {
    int nM, nN0, nwg0, nN1, nwg1, G, c;
    const char* A0; const char* B0; const char* A1; const char* B1; size_t tstep;
    __device__ __forceinline__ void init(int M, int K, const bf16_t* a0, const bf16_t* b0, int N0, const bf16_t* a1, const bf16_t* b1, int N1, int G_, int c_) {
        nM = M / BM; nN0 = N0 / BM; nwg0 = nM * nN0; nN1 = N1 / BM; nwg1 = nM * nN1; G = G_; c = c_;
        A0 = (const char*)a0; B0 = (const char*)b0; A1 = (const char*)a1; B1 = (const char*)b1; tstep = (size_t)BM * K * 2;
    }
    __device__ __forceinline__ void map(int wgid, int nwg, int nN, Unit& u) const {
        { const int q = nwg / NXCD, r = nwg % NXCD, xcd = wgid % NXCD, off = wgid / NXCD; wgid = (xcd < r ? xcd * (q + 1) : r * (q + 1) + (xcd - r) * q) + off; }
        const int nig = WGM * nN, gid = wgid / nig, fm = gid * WGM, gsz = (nM - fm) < WGM ? (nM - fm) : WGM;
        u.pm = fm + ((wgid % nig) % gsz); u.pn = (wgid % nig) / gsz;
    }
    __device__ __forceinline__ bool next(int i, Unit& u) const {
        const long L = (long)i * G + c;
        if (L < nwg0) { u.gi = 0; map((int)L, nwg0, nN0, u); return true; }
        if (L < nwg0 + nwg1) { u.gi = 1; map((int)(L - nwg0), nwg1, nN1, u); return true; }
        return false;
    }
    __device__ __forceinline__ const char* aptr(const Unit& u) const { return (u.gi ? A1 : A0) + (size_t)u.pm * tstep; }
    __device__ __forceinline__ const char* bptr(const Unit& u) const { return (u.gi ? B1 : B0) + (size_t)u.pn * tstep; }
};

template <class Epi, bool ALIGN_EPI, bool SP2>
__device__ __forceinline__ void gemm_phase(LAS unsigned char* lds, const int K, const Sched& S, const Epi& E) {
    const int tid = opaque_tid(), wid = __builtin_amdgcn_readfirstlane(tid >> 6), lane = tid & 63, wr = wid >> 2, wc = wid & 3, fr = lane & 15, fq = lane >> 4;
    const int nt = K / BK;
    unsigned voffA[2], voffB[2];
#pragma unroll
    for (int i = 0; i < 2; ++i) { int R, C; stage_rc(tid * 16 + i * 8192, R, C); const int Rb = Epi::PERM ? ((R & ~31) + perm32(R & 31)) : R;
        voffA[i] = (unsigned)(R * K + C) * 2u; voffB[i] = (unsigned)(Rb * K + C) * 2u; }
    const size_t kstep = (size_t)(BK * 2);
    const size_t hstep = (size_t)HALF * K * 2;
    const unsigned ldsw = (unsigned)wid * 1024u;
    const int aoff = lds_byte(wr * 64 + fr, fq * 8), boff = lds_byte(wc * 32 + fr, fq * 8);
#define PG8_SA(b, h) (((b) * 2 + (h)) * HTB)
#define PG8_SB(b, h) ((4 + (b) * 2 + (h)) * HTB)
#define PG8_STAGE(bufoff, gbase, voff) do { _Pragma("unroll") for (int _i = 0; _i < 2; ++_i) \
        __builtin_amdgcn_global_load_lds((const unsigned*)((const char*)(gbase) + (voff)[_i]), (LAS unsigned*)(lds + (bufoff) + ldsw + _i * 8192), 16, 0, 0); } while (0)
#define PG8_LDA(dst, b, h) do { _Pragma("unroll") for (int m = 0; m < 4; ++m) _Pragma("unroll") for (int k = 0; k < 2; ++k) dst[m][k] = *(const LAS bf16x8*)(lds + PG8_SA(b, h) + aoff + m * 2048 + k * 1024); } while (0)
#define PG8_LDB(dst, b, h) do { _Pragma("unroll") for (int n = 0; n < 2; ++n) _Pragma("unroll") for (int k = 0; k < 2; ++k) dst[n][k] = *(const LAS bf16x8*)(lds + PG8_SB(b, h) + boff + n * 2048 + k * 1024); } while (0)
#define PG8_MMA(ai, bj, At, Bt) do { __builtin_amdgcn_s_setprio(1); _Pragma("unroll") for (int m = 0; m < 4; ++m) _Pragma("unroll") for (int n = 0; n < 2; ++n) _Pragma("unroll") for (int k = 0; k < 2; ++k) \
        acc[ai][bj][m][n] = __builtin_amdgcn_mfma_f32_16x16x32_bf16(Bt[n][k], At[m][k], acc[ai][bj][m][n], 0, 0, 0); __builtin_amdgcn_s_setprio(0); } while (0)
#define PG8_WAIT_V(n) asm volatile("s_waitcnt vmcnt(" #n ")" ::: "memory")
#define PG8_WAIT_L(n) asm volatile("s_waitcnt lgkmcnt(" #n ")" ::: "memory")
#define PG8_BAR __builtin_amdgcn_s_barrier()
#define PG8_SCHED __builtin_amdgcn_sched_barrier(0)
    Unit cur, nxt; int ui = 0;
    if (!S.next(0, cur)) return;
    f32x4 acc[2][2][4][2];
#pragma unroll
    for (int a = 0; a < 2; ++a)
#pragma unroll
        for (int b = 0; b < 2; ++b)
#pragma unroll
            for (int m = 0; m < 4; ++m)
#pragma unroll
                for (int n = 0; n < 2; ++n) acc[a][b][m][n] = (f32x4){0.f, 0.f, 0.f, 0.f};
    bf16x8 At[4][2], B0[2][2], B1[2][2];
    const char* cA = S.aptr(cur); const char* cB = S.bptr(cur);
    if constexpr (SP2) {
        PG8_STAGE(PG8_SB(0, 0), cB, voffB); PG8_STAGE(PG8_SB(0, 1), cB + hstep, voffB); PG8_STAGE(PG8_SA(0, 0), cA, voffA); PG8_STAGE(PG8_SA(0, 1), cA + hstep, voffA);
        if (wr == 1) PG8_BAR;
        PG8_WAIT_V(2); PG8_BAR;
        PG8_STAGE(PG8_SB(1, 0), cB + kstep, voffB); PG8_STAGE(PG8_SA(1, 0), cA + kstep, voffA); PG8_STAGE(PG8_SB(1, 1), cB + hstep + kstep, voffB);
        PG8_WAIT_V(6); PG8_BAR;
    } else {
        PG8_STAGE(PG8_SB(0, 0), cB, voffB); PG8_STAGE(PG8_SA(0, 0), cA, voffA); PG8_STAGE(PG8_SB(0, 1), cB + hstep, voffB); PG8_STAGE(PG8_SA(0, 1), cA + hstep, voffA);
        if (wr == 1) PG8_BAR;
        PG8_WAIT_V(4); PG8_BAR;
        PG8_STAGE(PG8_SB(1, 0), cB + kstep, voffB); PG8_STAGE(PG8_SA(1, 0), cA + kstep, voffA); PG8_STAGE(PG8_SB(1, 1), cB + hstep + kstep, voffB);
        PG8_WAIT_V(6); PG8_BAR;
    }
    for (;;) {
        const bool has_next = S.next(ui + 1, nxt);
        const char* nA = has_next ? S.aptr(nxt) : cA; const char* nB = has_next ? S.bptr(nxt) : cB;
        for (int t = 0; t < nt; t += 2) {
            const bool last = (t == nt - 2);
            const char* a1 = cA + (size_t)(t + 1) * kstep;
            const char* a2 = last ? nA : cA + (size_t)(t + 2) * kstep; const char* b2 = last ? nB : cB + (size_t)(t + 2) * kstep;
            const char* a3 = a2 + kstep; const char* b3 = b2 + kstep;
            if constexpr (SP2) {
            PG8_LDB(B0, 0, 0); PG8_LDB(B1, 0, 1); PG8_SCHED; PG8_LDA(At, 0, 0); PG8_STAGE(PG8_SA(1, 1), a1 + hstep, voffA);
            PG8_WAIT_V(8); PG8_WAIT_L(0); PG8_BAR; PG8_MMA(0, 0, At, B0); PG8_MMA(0, 1, At, B1); PG8_BAR; PG8_SCHED;
            PG8_LDA(At, 0, 1); PG8_STAGE(PG8_SB(0, 0), b2, voffB); PG8_STAGE(PG8_SB(0, 1), b2 + hstep, voffB); PG8_STAGE(PG8_SA(0, 0), a2, voffA);
            PG8_WAIT_V(8); PG8_WAIT_L(0); PG8_BAR; PG8_MMA(1, 0, At, B0); PG8_MMA(1, 1, At, B1); PG8_BAR; PG8_SCHED;
            PG8_LDB(B0, 1, 0); PG8_LDB(B1, 1, 1); PG8_SCHED; PG8_LDA(At, 1, 0); PG8_STAGE(PG8_SA(0, 1), a2 + hstep, voffA);
            PG8_WAIT_V(8); PG8_WAIT_L(0); PG8_BAR; PG8_MMA(0, 0, At, B0); PG8_MMA(0, 1, At, B1); PG8_BAR; PG8_SCHED;
            PG8_LDA(At, 1, 1); PG8_STAGE(PG8_SB(1, 0), b3, voffB); PG8_STAGE(PG8_SB(1, 1), b3 + hstep, voffB); PG8_STAGE(PG8_SA(1, 0), a3, voffA);
            PG8_WAIT_V(8); PG8_WAIT_L(0); PG8_BAR; PG8_MMA(1, 0, At, B0); PG8_MMA(1, 1, At, B1); PG8_BAR; PG8_SCHED;
            } else {
            PG8_LDB(B0, 0, 0); PG8_SCHED; PG8_LDA(At, 0, 0); PG8_STAGE(PG8_SA(1, 1), a1 + hstep, voffA);
            PG8_WAIT_L(8); PG8_BAR; PG8_WAIT_L(0); PG8_MMA(0, 0, At, B0); PG8_BAR; PG8_SCHED;
            PG8_LDB(B1, 0, 1); PG8_STAGE(PG8_SB(0, 0), b2, voffB);
            PG8_BAR; PG8_WAIT_L(0); PG8_MMA(0, 1, At, B1); PG8_BAR;
            PG8_LDA(At, 0, 1); PG8_STAGE(PG8_SA(0, 0), a2, voffA);
            PG8_BAR; PG8_WAIT_L(0); PG8_MMA(1, 0, At, B0); PG8_BAR; PG8_SCHED;
            PG8_STAGE(PG8_SB(0, 1), b2 + hstep, voffB);
            PG8_WAIT_V(6); PG8_BAR; PG8_MMA(1, 1, At, B1); PG8_BAR;
            PG8_LDB(B0, 1, 0); PG8_SCHED; PG8_LDA(At, 1, 0); PG8_STAGE(PG8_SA(0, 1), a2 + hstep, voffA);
            PG8_WAIT_L(8); PG8_BAR; PG8_WAIT_L(0); PG8_MMA(0, 0, At, B0); PG8_BAR; PG8_SCHED;
            PG8_LDB(B1, 1, 1); PG8_STAGE(PG8_SB(1, 0), b3, voffB);
            PG8_BAR; PG8_WAIT_L(0); PG8_MMA(0, 1, At, B1); PG8_BAR;
            PG8_LDA(At, 1, 1); PG8_STAGE(PG8_SA(1, 0), a3, voffA);
            PG8_BAR; PG8_WAIT_L(0); PG8_MMA(1, 0, At, B0); PG8_BAR; PG8_SCHED;
            PG8_STAGE(PG8_SB(1, 1), b3 + hstep, voffB);
            PG8_WAIT_V(6); PG8_BAR; PG8_MMA(1, 1, At, B1); PG8_BAR;
            }
        }
        if constexpr (ALIGN_EPI) { if (wr == 0) PG8_BAR; }
        E(acc, cur, wr, wc, fr, fq);
        if (!has_next) break;
#pragma unroll
        for (int a = 0; a < 2; ++a)
#pragma unroll
            for (int b = 0; b < 2; ++b)
#pragma unroll
                for (int m = 0; m < 4; ++m)
#pragma unroll
                    for (int n = 0; n < 2; ++n) acc[a][b][m][n] = (f32x4){0.f, 0.f, 0.f, 0.f};
        cur = nxt; cA = nA; cB = nB; ++ui;
        if constexpr (ALIGN_EPI) { if (wr == 1) PG8_BAR; }
    }
    PG8_WAIT_V(0);
    if constexpr (!ALIGN_EPI) { if (wr == 0) PG8_BAR; }
    PG8_BAR;
#undef PG8_SA
#undef PG8_SB
#undef PG8_STAGE
#undef PG8_LDA
#undef PG8_LDB
#undef PG8_MMA
#undef PG8_WAIT_V
#undef PG8_WAIT_L
#undef PG8_BAR
#undef PG8_SCHED
}
}

#define EPI_ROWS_BEGIN() const int row0 = u.pm * 256 + wr * 64 + fr; const int cl0 = wc * 32 + 8 * fq;
__device__ __forceinline__ u32x4 pack8s(f32x4 a, f32x4 b, float s) {
    u32x4 w; w.x = cvt_pk_bf16(a[0] * s, a[1] * s); w.y = cvt_pk_bf16(a[2] * s, a[3] * s); w.z = cvt_pk_bf16(b[0] * s, b[1] * s); w.w = cvt_pk_bf16(b[2] * s, b[3] * s); return w;
}
__device__ __forceinline__ float sumsq8(f32x4 a, f32x4 b, float s) {
    a = a * s; b = b * s; return (a[0] * a[0] + a[1] * a[1]) + (a[2] * a[2] + a[3] * a[3]) + (b[0] * b[0] + b[1] * b[1]) + (b[2] * b[2] + b[3] * b[3]);
}
__device__ __forceinline__ void rope8(f32x4& a, f32x4& b, const float* ctab, const float* stab, int row, int i0) {
    const f32x4 cs = *(const f32x4*)(ctab + (size_t)row * 32 + i0), sn = *(const f32x4*)(stab + (size_t)row * 32 + i0);
    const f32x4 a2 = (f32x4){a[0] * cs[0] - a[1] * sn[0], a[0] * sn[0] + a[1] * cs[0], a[2] * cs[1] - a[3] * sn[1], a[2] * sn[1] + a[3] * cs[1]};
    const f32x4 b2 = (f32x4){b[0] * cs[2] - b[1] * sn[2], b[0] * sn[2] + b[1] * cs[2], b[2] * cs[3] - b[3] * sn[3], b[2] * sn[3] + b[3] * cs[3]};
    a = a2; b = b2;
}

struct EpiMlaIn {
    static constexpr bool PERM = true;
    bf16_t* CQ; bf16_t* CKV; bf16_t* KR; float* SSQ; const float* rsh; const float* ctab; const float* stab;
    __device__ __forceinline__ void operator()(const f32x4 (&acc)[2][2][4][2], const pg8::Unit& u, int wr, int wc, int fr, int fq) const {
        EPI_ROWS_BEGIN();
        if (u.pn < 4) {
            bf16_t* base = (u.pn < 2 ? CQ : CKV) + (u.pn & 1) * 256;
#pragma unroll
            for (int ai = 0; ai < 2; ++ai)
#pragma unroll
                for (int m = 0; m < 4; ++m) { const int row = row0 + ai * 128 + m * 16; const float rs = rsh[row]; float ss = 0.f;
#pragma unroll
                    for (int bj = 0; bj < 2; ++bj) { *(u32x4*)(base + (size_t)row * 512 + bj * 128 + cl0) = pack8s(acc[ai][bj][m][0], acc[ai][bj][m][1], rs); ss += sumsq8(acc[ai][bj][m][0], acc[ai][bj][m][1], rs); }
                    ss += __shfl_xor(ss, 16); ss += __shfl_xor(ss, 32);
                    if (fq == 0) SSQ[(size_t)row * 16 + (u.pn >> 1) * 8 + (u.pn & 1) * 4 + wc] = ss; }
        } else if (wc < 2) {
#pragma unroll
            for (int ai = 0; ai < 2; ++ai)
#pragma unroll
                for (int m = 0; m < 4; ++m) { const int row = row0 + ai * 128 + m * 16; const float rs = rsh[row];
                    f32x4 a = acc[ai][0][m][0] * rs, b = acc[ai][0][m][1] * rs; rope8(a, b, ctab, stab, row, cl0 >> 1);
                    *(u32x4*)(KR + (size_t)row * 64 + cl0) = pack8s(a, b, 1.f); }
        }
    }
};
struct EpiMlaUp {
    static constexpr bool PERM = true;
    bf16_t* Q; bf16_t* KN; bf16_t* V; const float* SSQ; const float* ctab; const float* stab;
    __device__ __forceinline__ void operator()(const f32x4 (&acc)[2][2][4][2], const pg8::Unit& u, int wr, int wc, int fr, int fq) const {
        EPI_ROWS_BEGIN();
#pragma unroll
        for (int ai = 0; ai < 2; ++ai)
#pragma unroll
            for (int m = 0; m < 4; ++m) { const int row = row0 + ai * 128 + m * 16;
                const f32x4 s0 = *(const f32x4*)(SSQ + (size_t)row * 16 + u.gi * 8), s1 = *(const f32x4*)(SSQ + (size_t)row * 16 + u.gi * 8 + 4);
                const float ss = ((s0[0] + s0[1]) + (s0[2] + s0[3])) + ((s1[0] + s1[1]) + (s1[2] + s1[3]));
                const float rs = rsqrtf(ss * (1.0f / 512.0f) + EPS);
                if (u.gi == 0) {
#pragma unroll
                    for (int bj = 0; bj < 2; ++bj) { const int col = u.pn * 256 + bj * 128 + cl0; const int w = col % DQK;
                        f32x4 a = acc[ai][bj][m][0] * rs, b = acc[ai][bj][m][1] * rs;
                        if (w >= 128) rope8(a, b, ctab, stab, row, (w - 128) >> 1);
                        *(u32x4*)(Q + (size_t)row * NQUP + col) = pack8s(a, b, 1.f); }
                } else {
                    *(u32x4*)(KN + (size_t)row * D + u.pn * 128 + cl0) = pack8s(acc[ai][0][m][0], acc[ai][0][m][1], rs);
                    *(u32x4*)(V + (size_t)row * D + u.pn * 128 + cl0) = pack8s(acc[ai][1][m][0], acc[ai][1][m][1], rs);
                } }
    }
};
struct EpiMix {
    static constexpr bool PERM = true;
    bf16_t* MIX; float* SSM;
    __device__ __forceinline__ void operator()(const f32x4 (&acc)[2][2][4][2], const pg8::Unit& u, int wr, int wc, int fr, int fq) const {
        EPI_ROWS_BEGIN();
#pragma unroll
        for (int ai = 0; ai < 2; ++ai)
#pragma unroll
            for (int m = 0; m < 4; ++m) { const int row = row0 + ai * 128 + m * 16; float ss = 0.f;
#pragma unroll
                for (int bj = 0; bj < 2; ++bj) { *(u32x4*)(MIX + (size_t)row * D + u.pn * 256 + bj * 128 + cl0) = pack8s(acc[ai][bj][m][0], acc[ai][bj][m][1], 1.f); ss += sumsq8(acc[ai][bj][m][0], acc[ai][bj][m][1], 1.f); }
                ss += __shfl_xor(ss, 16); ss += __shfl_xor(ss, 32);
                if (fq == 0) SSM[(size_t)row * 32 + u.pn * 4 + wc] = ss; }
    }
};
struct EpiFfnUp {
    static constexpr bool PERM = true;
    bf16_t* U; const float* rsh;
    __device__ __forceinline__ void operator()(const f32x4 (&acc)[2][2][4][2], const pg8::Unit& u, int wr, int wc, int fr, int fq) const {
        EPI_ROWS_BEGIN();
#pragma unroll
        for (int ai = 0; ai < 2; ++ai)
#pragma unroll
            for (int m = 0; m < 4; ++m) { const int row = row0 + ai * 128 + m * 16; const float rs = rsh[row];
#pragma unroll
                for (int bj = 0; bj < 2; ++bj) *(u32x4*)(U + (size_t)row * FF2 + u.pn * 256 + bj * 128 + cl0) = pack8s(acc[ai][bj][m][0], acc[ai][bj][m][1], rs); }
    }
};
struct EpiMobaKvq {
    static constexpr bool PERM = true;
    unsigned char* wsb; float* KMEAN; const float* rsh; int pn_off;
    __device__ __forceinline__ void operator()(const f32x4 (&acc)[2][2][4][2], const pg8::Unit& u, int wr, int wc, int fr, int fq) const {
        EPI_ROWS_BEGIN();
        const int pe = u.pn + pn_off;
        bf16_t* base = (bf16_t*)(wsb + (pe < 16 ? WS_KB + (size_t)(pe >> 3) * (WS_VB - WS_KB) : WS_Q)); const int ct = (pe & 7) * 256;
        f32x4 cs00 = (f32x4){0.f, 0.f, 0.f, 0.f}, cs01 = cs00, cs10 = cs00, cs11 = cs00;
#pragma unroll
        for (int ai = 0; ai < 2; ++ai)
#pragma unroll
            for (int m = 0; m < 4; ++m) { const int row = row0 + ai * 128 + m * 16; const float rs = rsh[row];
#pragma unroll
                for (int bj = 0; bj < 2; ++bj) *(u32x4*)(base + (size_t)row * D + ct + bj * 128 + cl0) = pack8s(acc[ai][bj][m][0], acc[ai][bj][m][1], rs);
                cs00 += acc[ai][0][m][0] * rs; cs01 += acc[ai][0][m][1] * rs; cs10 += acc[ai][1][m][0] * rs; cs11 += acc[ai][1][m][1] * rs; }
        if (pe < 8) {
#define KM_ADD(CS, bj, n) do { _Pragma("unroll") for (int e = 0; e < 4; ++e) { float v = CS[e]; v += __shfl_xor(v, 1); v += __shfl_xor(v, 2); v += __shfl_xor(v, 4); v += __shfl_xor(v, 8); \
                if (fr == 0) (void)__hip_atomic_fetch_add(KMEAN + (size_t)u.pm * D + ct + (bj) * 128 + cl0 + (n) * 4 + e, v, __ATOMIC_RELAXED, __HIP_MEMORY_SCOPE_AGENT); } } while (0)
            KM_ADD(cs00, 0, 0); KM_ADD(cs01, 0, 1); KM_ADD(cs10, 1, 0); KM_ADD(cs11, 1, 1);
#undef KM_ADD
        }
    }
};

namespace att {
constexpr int V_OFF = 0, KN_OFF = 16384, KR_OFF = 32768, BUF_BYTES = 40960;
constexpr int WS_OFF = 2 * BUF_BYTES, BT_OFF = WS_OFF + 8 * 64 * 4, ATT_LDS = BT_OFF + 512;
#define KSWZ(row, colB) ((row) * 256 + ((colB) ^ (((row) & 7) << 4)))
#define RSWZ(row, colB) ((row) * 128 + ((colB) ^ (((row) & 7) << 4)))
__device__ __forceinline__ int v_st(int k, int c) { const int kk = (k & ~0xC) | ((k & 4) << 1) | ((k & 8) >> 1); return ((kk >> 3) * 4 + (c >> 5)) * 512 + ((kk & 7) * 32 + (c & 31)) * 2; }
__device__ __forceinline__ int v_rd_base(int lane) { return ((lane & 3) << 3) | (((lane >> 2) & 3) << 6) | (((lane >> 4) & 1) << 5) | (((lane >> 5) & 1) << 8); }
constexpr int v_rd_off(int d0, int ks, int half) { return d0 * 512 + ks * 4096 + half * 2048; }
__device__ __forceinline__ int crow(int r, int hi) { return (r & 3) + 8 * (r >> 2) + 4 * hi; }

struct Args { const bf16_t* Q; const bf16_t* K; const bf16_t* KR; const bf16_t* V; bf16_t* O; const unsigned* SEL; const float* relb; const int* pos; };

template <int BUF>
__device__ __forceinline__ void pv_tile(f32x16* o, int vb0, bf16x8 pa0, bf16x8 pa1, bf16x8 pa2, bf16x8 pa3) {
#define TRRD(dst, off) asm volatile("ds_read_b64_tr_b16 %0, %1 offset:%2" : "=&v"(dst) : "v"(vb0), "i"(off) : "memory")
#define PV_D0(d0) do { s16x4 l0, l1, l2, l3, h0, h1, h2, h3; constexpr int b_ = BUF * BUF_BYTES + V_OFF + v_rd_off(d0, 0, 0); \
        TRRD(l0, b_); TRRD(h0, b_ + 2048); TRRD(l1, b_ + 4096); TRRD(h1, b_ + 6144); TRRD(l2, b_ + 8192); TRRD(h2, b_ + 10240); TRRD(l3, b_ + 12288); TRRD(h3, b_ + 14336); \
        asm volatile("s_waitcnt lgkmcnt(0)" ::: "memory"); SBAR(); \
        o[d0] = __builtin_amdgcn_mfma_f32_32x32x16_bf16(pa0, (bf16x8){l0[0], l0[1], l0[2], l0[3], h0[0], h0[1], h0[2], h0[3]}, o[d0], 0, 0, 0); \
        o[d0] = __builtin_amdgcn_mfma_f32_32x32x16_bf16(pa1, (bf16x8){l1[0], l1[1], l1[2], l1[3], h1[0], h1[1], h1[2], h1[3]}, o[d0], 0, 0, 0); \
        o[d0] = __builtin_amdgcn_mfma_f32_32x32x16_bf16(pa2, (bf16x8){l2[0], l2[1], l2[2], l2[3], h2[0], h2[1], h2[2], h2[3]}, o[d0], 0, 0, 0); \
        o[d0] = __builtin_amdgcn_mfma_f32_32x32x16_bf16(pa3, (bf16x8){l3[0], l3[1], l3[2], l3[3], h3[0], h3[1], h3[2], h3[3]}, o[d0], 0, 0, 0); } while (0)
    PV_D0(0); PV_D0(1); PV_D0(2); PV_D0(3);
#undef PV_D0
#undef TRRD
}

template <bool MOBA>
__device__ __forceinline__ void attn_unit(LAS unsigned char* lds, const Args& T, int h, int qb) {
    constexpr int NDQ = MOBA ? 8 : 12, QPITCH = MOBA ? 2048 : 3072, HD = MOBA ? 128 : 192;
    constexpr float SCALE = MOBA ? 0.08838834764831845f : 0.07216878364870323f;
    constexpr float C2 = 1.4426950408889634f * SCALE, THR = 8.f;
    const int tid = opaque_tid(), wid = __builtin_amdgcn_readfirstlane(tid >> 6), lane = tid & 63, r32 = lane & 31, hi = lane >> 5;
    const int q0 = qb * 256, qlo = q0 + wid * 32, qrow = qlo + r32, NT = 4 * (qb + 1), own = qb;
    LAS float* wsf = (LAS float*)(lds + WS_OFF) + wid * 64; LAS float* li_l = wsf; LAS float* al_l = wsf + 32;
    LAS float* btab = (LAS float*)(lds + BT_OFF);
    bf16x8 qr[NDQ];
    { const bf16_t* Qp = T.Q + (size_t)qrow * QPITCH + h * HD + hi * 8;
#pragma unroll
      for (int d0 = 0; d0 < NDQ; ++d0) qr[d0] = *(const bf16x8*)(Qp + d0 * 16); }
    unsigned selm = 0u; int pq = 0;
    if (MOBA) { selm = T.SEL[(size_t)qrow * NH + h]; pq = T.pos[qrow];
        if (tid < 128) { int n = tid, b = n;
            if (n >= 16) { b = 16 + (int)(logf((float)n * (1.0f / 16.0f)) / 2.0794415416798357f * 16.0f); b = b > 31 ? 31 : b; }
            btab[tid] = (T.relb[b * NH + h] - T.relb[31 * NH + h]) * (1.0f / SCALE); } }
    unsigned vk[2], vv[2], vr = 0u;
#pragma unroll
    for (int i = 0; i < 2; ++i) { const int pb = (wid + 8 * i) * 1024 + lane * 16;
        { const int row = pb >> 8, ch = ((pb & 255) >> 4) ^ (row & 7); vk[i] = (unsigned)(row * (D * 2) + ch * 16); }
        { const int sub = pb >> 9, w = (pb & 511) >> 1, kk = (sub >> 2) * 8 + (w >> 5), c = (sub & 3) * 32 + (w & 31);
          const int k = (kk & ~0xC) | ((kk & 4) << 1) | ((kk & 8) >> 1); vv[i] = (unsigned)(k * (D * 2) + c * 2); } }
    if (!MOBA) { const int pb = wid * 1024 + lane * 16, row = pb >> 7, ch = ((pb & 127) >> 4) ^ (row & 7); vr = (unsigned)(row * 128 + ch * 16); }
    const char* Kg = (const char*)(T.K + h * 128); const char* Vg = (const char*)(T.V + h * 128); const char* Rg = (const char*)T.KR;
#define GLDS(g, l) __builtin_amdgcn_global_load_lds((const unsigned*)(g), (LAS unsigned*)(l), 16, 0, 0)
#define DMA_TILE(kb, bf) do { const char* kt_ = Kg + (size_t)(kb) * (D * 2); const char* vt_ = Vg + (size_t)(kb) * (D * 2); \
        GLDS(kt_ + vk[0], lds + (bf) * BUF_BYTES + KN_OFF + wid * 1024); GLDS(kt_ + vk[1], lds + (bf) * BUF_BYTES + KN_OFF + (wid + 8) * 1024); \
        GLDS(vt_ + vv[0], lds + (bf) * BUF_BYTES + V_OFF + wid * 1024); GLDS(vt_ + vv[1], lds + (bf) * BUF_BYTES + V_OFF + (wid + 8) * 1024); \
        if (!MOBA) GLDS(Rg + (size_t)(kb) * 128 + vr, lds + (bf) * BUF_BYTES + KR_OFF + wid * 1024); } while (0)
    const int vb0 = (int)(unsigned)(uintptr_t)(lds) + v_rd_base(lane);
    int kna[4], kra[4];
#pragma unroll
    for (int dd = 0; dd < 4; ++dd) { kna[dd] = KN_OFF + KSWZ(r32, (dd * 16 + hi * 8) * 2); kra[dd] = KR_OFF + RSWZ(r32, (dd * 16 + hi * 8) * 2); }
    float m_reg = -1e30f, l_reg = 0.f; f32x16 o[4];
#pragma unroll
    for (int d = 0; d < 4; ++d) o[d] = f32x16{};
    DMA_TILE(0, 0); VM_WAIT(); __syncthreads();

#define ATT_STEP(t, BUF) do { const int kb = (t) * 64; \
        if ((t) + 1 < NT) DMA_TILE(kb + 64, (BUF) ^ 1); \
        bool keep = true; const int blk = (t) >> 2; \
        if (MOBA && blk < own) keep = ((selm >> blk) & 1u) != 0u; \
        if (!MOBA || __any(keep)) { \
            f32x16 p0 = f32x16{}, p1 = f32x16{}; \
            _Pragma("unroll") for (int d0 = 0; d0 < 8; ++d0) { const LAS unsigned char* a = lds + (BUF) * BUF_BYTES + kna[d0 & 3] + (d0 >> 2) * 128; \
                const bf16x8 b0 = *(const LAS bf16x8*)a, b1 = *(const LAS bf16x8*)(a + 32 * 256); \
                p0 = __builtin_amdgcn_mfma_f32_32x32x16_bf16(b0, qr[d0], p0, 0, 0, 0); p1 = __builtin_amdgcn_mfma_f32_32x32x16_bf16(b1, qr[d0], p1, 0, 0, 0); } \
            if (!MOBA) { _Pragma("unroll") for (int d0 = 0; d0 < 4; ++d0) { const LAS unsigned char* a = lds + (BUF) * BUF_BYTES + kra[d0]; \
                const bf16x8 b0 = *(const LAS bf16x8*)a, b1 = *(const LAS bf16x8*)(a + 32 * 128); \
                p0 = __builtin_amdgcn_mfma_f32_32x32x16_bf16(b0, qr[(NDQ - 4) + d0], p0, 0, 0, 0); p1 = __builtin_amdgcn_mfma_f32_32x32x16_bf16(b1, qr[(NDQ - 4) + d0], p1, 0, 0, 0); } } \
            const float NEGINF = -__builtin_inff(); \
            if (MOBA) { \
                if (!keep) { _Pragma("unroll") for (int r = 0; r < 16; ++r) { p0[r] = NEGINF; p1[r] = NEGINF; } } \
                if (T.pos[qlo] - T.pos[kb + 63] < 128) {     \
                    _Pragma("unroll") for (int g = 0; g < 4; ++g) { const i32x4 pk0 = *(const i32x4*)(T.pos + kb + 8 * g + 4 * hi), pk1 = *(const i32x4*)(T.pos + kb + 32 + 8 * g + 4 * hi); \
                        _Pragma("unroll") for (int e = 0; e < 4; ++e) { const int d0_ = pq - pk0[e], d1_ = pq - pk1[e]; \
                            if ((unsigned)d0_ < 128u) p0[4 * g + e] += btab[d0_]; if ((unsigned)d1_ < 128u) p1[4 * g + e] += btab[d1_]; } } } \
            } \
            if (kb + 63 > qlo) { _Pragma("unroll") for (int r = 0; r < 16; ++r) { const int c = kb + crow(r, hi); if (c > qrow) p0[r] = NEGINF; if (c + 32 > qrow) p1[r] = NEGINF; } } \
            float pmax = p0[0]; _Pragma("unroll") for (int r = 1; r < 16; ++r) pmax = fmaxf(pmax, p0[r]); _Pragma("unroll") for (int r = 0; r < 16; ++r) pmax = fmaxf(pmax, p1[r]); \
            { auto rr_ = __builtin_amdgcn_permlane32_swap(__float_as_uint(pmax), __float_as_uint(pmax), false, false); pmax = fmaxf(__uint_as_float(rr_[0]), __uint_as_float(rr_[1])); } \
            float mn, alpha; \
            if (__all((pmax - m_reg) * SCALE <= THR)) { mn = m_reg; alpha = 1.f; } \
            else { mn = fmaxf(m_reg, pmax); alpha = __builtin_amdgcn_exp2f((m_reg - mn) * C2); m_reg = mn; } \
            const float mnL = -mn * C2; \
            _Pragma("unroll") for (int r = 0; r < 16; ++r) { p0[r] = __builtin_amdgcn_exp2f(fmaf(p0[r], C2, mnL)); p1[r] = __builtin_amdgcn_exp2f(fmaf(p1[r], C2, mnL)); } \
            float ps = 0.f; _Pragma("unroll") for (int r = 0; r < 16; ++r) ps += p0[r]; _Pragma("unroll") for (int r = 0; r < 16; ++r) ps += p1[r]; \
            { auto rr_ = __builtin_amdgcn_permlane32_swap(__float_as_uint(ps), __float_as_uint(ps), false, false); ps = __uint_as_float(rr_[0]) + __uint_as_float(rr_[1]); } \
            l_reg = l_reg * alpha + ps; \
            bf16x8 pa0, pa1, pa2, pa3; \
            PK4(p0, 0, pa0); PK4(p0, 8, pa1); PK4(p1, 0, pa2); PK4(p1, 8, pa3); \
            if (__any(alpha < 1.f)) { if (hi == 0) al_l[r32] = alpha; LDS_WAIT(); \
                _Pragma("unroll") for (int d_ = 0; d_ < 4; ++d_) _Pragma("unroll") for (int r = 0; r < 16; ++r) o[d_][r] *= al_l[crow(r, hi)]; } \
            SBAR(); pv_tile<BUF>(o, vb0, pa0, pa1, pa2, pa3); \
        } \
        VM_WAIT(); __syncthreads(); } while (0)
#define PK4(P, B_, OUT) do { unsigned a0_ = cvt_pk_bf16(P[B_ + 0], P[B_ + 1]), a1_ = cvt_pk_bf16(P[B_ + 2], P[B_ + 3]); \
        unsigned b0_ = cvt_pk_bf16(P[B_ + 4], P[B_ + 5]), b1_ = cvt_pk_bf16(P[B_ + 6], P[B_ + 7]); \
        auto r0_ = __builtin_amdgcn_permlane32_swap(a0_, b0_, false, false); auto r1_ = __builtin_amdgcn_permlane32_swap(a1_, b1_, false, false); \
        u32x4 w_ = {r0_[0], r1_[0], r0_[1], r1_[1]}; OUT = __builtin_bit_cast(bf16x8, w_); } while (0)

    for (int t = 0; t < NT; t += 2) { ATT_STEP(t, 0); ATT_STEP(t + 1, 1); }
#undef PK4
#undef ATT_STEP
#undef DMA_TILE
#undef GLDS
    if (hi == 0) li_l[r32] = l_reg; LDS_WAIT();
    bf16_t* Ow = T.O + (size_t)qlo * D + h * 128;
#pragma unroll
    for (int r = 0; r < 16; ++r) { const int orow = crow(r, hi); const float rl = __builtin_amdgcn_rcpf(li_l[orow]);
#pragma unroll
        for (int d0 = 0; d0 < 4; ++d0) { const float v = o[d0][r] * rl; const float vn = __shfl_xor(v, 1);
            if ((r32 & 1) == 0) *(unsigned*)(Ow + (size_t)orow * D + d0 * 32 + r32) = cvt_pk_bf16(v, vn); } }
    __syncthreads();
}
}

#define XB_TMO      128
#define XB_XCNT(j)  (256  + 64 * (j))
#define XB_XSUB(j)  (1280 + 64 * (j))
#define XB_XGEN(j)  (2304 + 64 * (j))
#define XB_TOP      3328
#define XB_TOPGEN   3392
#define XCD_BAR_WORDS 3456
#define XB_SPIN_CAP (1u << 18)
__device__ __forceinline__ unsigned xb_ld(unsigned* p)              { return __hip_atomic_load(p, __ATOMIC_RELAXED, __HIP_MEMORY_SCOPE_AGENT); }
__device__ __forceinline__ unsigned xb_add(unsigned* p, unsigned v) { return __hip_atomic_fetch_add(p, v, __ATOMIC_RELAXED, __HIP_MEMORY_SCOPE_AGENT); }
__device__ __forceinline__ unsigned xb_xcc_id() { return (unsigned)__builtin_amdgcn_s_getreg((3 << 11) | 20) & 0xFu; }
#define XB_SPIN(cond, bar) do { unsigned _sp = 0; while (cond) { __builtin_amdgcn_s_sleep(1); \
    if ((++_sp & 255u) == 0u) { if (xb_ld(&(bar)[XB_TMO])) break; if (_sp > XB_SPIN_CAP) { atomicAdd(&(bar)[XB_TMO], 1u); break; } } } } while (0)
struct XcdBarrier { unsigned* bar; unsigned x; volatile LAS unsigned* st; };
__device__ __forceinline__ XcdBarrier xcd_barrier_post(unsigned* bar, volatile LAS unsigned* st) {
    XcdBarrier b; b.bar = bar; b.x = xb_xcc_id(); b.st = st;
    if (threadIdx.x == 0) (void)xb_add(&bar[XB_XCNT(b.x)], 1u);
    return b;
}
__device__ __forceinline__ void xcd_barrier_complete(unsigned* bar, unsigned x, unsigned& nloc, unsigned& nx) {
    const unsigned G = gridDim.x * gridDim.y * gridDim.z;
    unsigned sum, cnt, mine, sp = 0u;
    for (;;) {
        sum = 0u; cnt = 0u; mine = 0u;
#pragma unroll
        for (unsigned j = 0; j < 16; ++j) { const unsigned c = xb_ld(&bar[XB_XCNT(j)]); sum += c; cnt += (c > 0u) ? 1u : 0u; mine = (j == x) ? c : mine; }
        if (sum == G) break;
        __builtin_amdgcn_s_sleep(1);
        if ((++sp & 255u) == 0u) { if (xb_ld(&bar[XB_TMO])) break; if (sp > XB_SPIN_CAP) { atomicAdd(&bar[XB_TMO], 1u); break; } }
    }
    nloc = mine > 0u ? mine : 1u; nx = cnt > 0u ? cnt : 1u;
}
__device__ __forceinline__ void xcd_barrier(const XcdBarrier& b) {
    asm volatile("s_waitcnt vmcnt(0)" ::: "memory");
    __syncthreads();
    if (threadIdx.x == 0) {
        unsigned* bar = b.bar;
        __builtin_amdgcn_s_waitcnt(0);
        unsigned nloc = b.st[0], nx = b.st[1];
        if (nloc == 0u) { xcd_barrier_complete(bar, b.x, nloc, nx); b.st[0] = nloc; b.st[1] = nx; }
        const unsigned old = xb_add(&bar[XB_XSUB(b.x)], 1u);
        const unsigned gen = old / nloc;
        if (old + 1u == (gen + 1u) * nloc) {
            __builtin_amdgcn_fence(__ATOMIC_RELEASE, "agent");
            asm volatile("s_waitcnt vmcnt(0)" ::: "memory");
            const unsigned og = xb_add(&bar[XB_TOP], 1u);
            const unsigned tg = og / nx;
            if (og + 1u == (tg + 1u) * nx) xb_add(&bar[XB_TOPGEN], 1u);
            else XB_SPIN(xb_ld(&bar[XB_TOPGEN]) == tg, bar);
            __builtin_amdgcn_fence(__ATOMIC_ACQUIRE, "agent");
            xb_add(&bar[XB_XGEN(b.x)], 1u);
            asm volatile("s_waitcnt vmcnt(0)" ::: "memory");
        } else {
            XB_SPIN(xb_ld(&bar[XB_XGEN(b.x)]) == gen, bar);
            __builtin_amdgcn_fence(__ATOMIC_ACQUIRE, "agent");
            asm volatile("s_waitcnt vmcnt(0)" ::: "memory");
        }
    }
    __syncthreads();
}

struct Params {
    const float* x; const int* pos; const float* gains; const float* a_w_in; const float* a_q_norm; const float* a_w_q_up; const float* a_kv_norm; const float* a_w_kv_up;
    const float* a_w_o; const float* b_kv_norm; const float* b_w_kv; const float* b_w_q; const float* b_w_o; const float* rel_bias; const float* ffn_w_in; const float* ffn_conv_w;
    const float* ffn_conv_b; const float* ffn_w_out; float* out; unsigned char* ws; int ph_lo, ph_hi;
};

struct WDesc { const float* src; const float* gain; bf16_t* dst; int K, Nsrc, Ndst, map; };
__device__ __forceinline__ int colmap(int map, int n) {
    if (map == 1) { if (n < 1024) return n; if (n >= NIN) return -1; const int j = n - 1024; return 1024 + (j >> 1) + (j & 1) * 32; }
    if (map == 2) { const int hh = n / DQK, w = n % DQK; if (w < 128) return n; const int j = w - 128; return hh * DQK + 128 + (j >> 1) + (j & 1) * 32; }
    return n;
}
__device__ __forceinline__ WDesc wdesc(const Params& p, int i) {
    WDesc w; bf16_t* ws = (bf16_t*)p.ws; w.gain = nullptr; w.map = 0;
    if (i < 2) { w.src = p.a_w_in + (size_t)i * D * NIN; w.gain = p.gains + (size_t)(i * 4 + 0) * D; w.dst = (bf16_t*)(p.ws + WS_WIN) + (size_t)i * NINP * D; w.K = D; w.Nsrc = NIN; w.Ndst = NINP; w.map = 1; }
    else if (i < 4) { const int l = i - 2; w.src = p.a_w_q_up + (size_t)l * QL * NQUP; w.gain = p.a_q_norm + l * QL; w.dst = (bf16_t*)(p.ws + WS_WUPG) + (size_t)l * 7168 * 512; w.K = QL; w.Nsrc = NQUP; w.Ndst = NQUP; w.map = 2; }
    else if (i < 6) { const int l = i - 4; w.src = p.a_w_kv_up + (size_t)l * KVL * NKVUP; w.gain = p.a_kv_norm + l * KVL; w.dst = (bf16_t*)(p.ws + WS_WUPG) + (size_t)l * 7168 * 512 + (size_t)NQUP * 512; w.K = KVL; w.Nsrc = NKVUP; w.Ndst = NKVUP; }
    else if (i < 10) { const int l = i - 6; w.src = (l < 2 ? p.a_w_o + (size_t)l * D * D : p.b_w_o + (size_t)(l - 2) * D * D); w.dst = (bf16_t*)(p.ws + WS_WO) + (size_t)l * D * D; w.K = D; w.Nsrc = D; w.Ndst = D; }
    else if (i == 10) { w.src = p.b_w_kv; w.gain = p.b_kv_norm; w.dst = (bf16_t*)(p.ws + WS_WKVQ); w.K = D; w.Nsrc = 4096; w.Ndst = 4096; }
    else if (i == 11) { w.src = p.b_w_q; w.gain = p.gains + (size_t)(2 * 4 + 0) * D; w.dst = (bf16_t*)(p.ws + WS_WKVQ) + (size_t)4096 * D; w.K = D; w.Nsrc = D; w.Ndst = D; }
    else if (i == 12) { w.src = p.b_w_q + (size_t)D * D; w.gain = p.gains + (size_t)(3 * 4 + 0) * D; w.dst = (bf16_t*)(p.ws + WS_WQ1); w.K = D; w.Nsrc = D; w.Ndst = D; }
    else if (i < 17) { const int l = i - 13; w.src = p.ffn_w_in + (size_t)l * D * FF2; w.gain = p.gains + (size_t)(l * 4 + 2) * D; w.dst = (bf16_t*)(p.ws + WS_WUP) + (size_t)l * FF2 * D; w.K = D; w.Nsrc = FF2; w.Ndst = FF2; }
    else { const int l = i - 17; w.src = p.ffn_w_out + (size_t)l * FF * D; w.dst = (bf16_t*)(p.ws + WS_WDN) + (size_t)l * D * FF; w.K = FF; w.Nsrc = D; w.Ndst = D; }
    (void)ws; return w;
}
constexpr int NWDESC = 21;
__device__ __forceinline__ void transpose_item(const WDesc& w, LAS float* scr, int item, int lane) {
    const int nblk = w.Ndst / 32, kb = item / nblk, nb = item % nblk, k0 = 64 * kb, n0 = 32 * nb;
    const int sn = colmap(w.map, n0 + (lane & 31));
#pragma unroll 8
    for (int i = 0; i < 32; ++i) { const int kk = 2 * i + (lane >> 5); float v = 0.f;
        if (sn >= 0) { v = w.src[(size_t)(k0 + kk) * w.Nsrc + sn]; if (w.gain) v *= w.gain[k0 + kk]; }
        scr[kk * 33 + (lane & 31)] = v; }
    LDS_WAIT(); asm volatile("" ::: "memory");
    const int c = lane & 7;
#pragma unroll
    for (int j = 0; j < 4; ++j) { const int n = (lane >> 3) + 8 * j; const LAS float* s = scr + (8 * c) * 33 + n;
        u32x4 o; o.x = cvt_pk_bf16(s[0 * 33], s[1 * 33]); o.y = cvt_pk_bf16(s[2 * 33], s[3 * 33]); o.z = cvt_pk_bf16(s[4 * 33], s[5 * 33]); o.w = cvt_pk_bf16(s[6 * 33], s[7 * 33]);
        *(u32x4*)(w.dst + (size_t)(n0 + n) * w.K + k0 + 8 * c) = o; }
    LDS_WAIT(); asm volatile("" ::: "memory");
}
__device__ __forceinline__ void prologue_phase(const Params& p, LAS unsigned char* lds, int vcu, int G, int wave, int lane) {
    LAS float* scr = (LAS float*)(lds + wave * 16384);
    const int gw = vcu * NWAVES + wave, NGW = G * NWAVES;
    int start = gw;
    for (int d = 0; d < NWDESC; ++d) { const WDesc w = wdesc(p, d); const int n = (w.K / 64) * (w.Ndst / 32);
        int it = start; for (; it < n; it += NGW) transpose_item(w, scr, it, lane);
        start = it - n; }
    bf16_t* HB = (bf16_t*)(p.ws + WS_HB); float* RSH = (float*)(p.ws + WS_RSH);
    for (int row = gw; row < S; row += NGW) { const float* xr = p.x + (size_t)row * D; float ss = 0.f;
#pragma unroll
        for (int j = 0; j < 4; ++j) { const f32x4 a = *(const f32x4*)(xr + j * 512 + lane * 8), b = *(const f32x4*)(xr + j * 512 + lane * 8 + 4);
            ss += sumsq8(a, b, 1.f); *(u32x4*)(HB + (size_t)row * D + j * 512 + lane * 8) = pack8s(a, b, 1.f); }
        ss = wave_sum(ss); if (lane == 0) RSH[row] = rsqrtf(ss * (1.0f / D) + EPS); }
    { float* RC = (float*)(p.ws + WS_RCOS); float* RS = (float*)(p.ws + WS_RSIN);
      for (int i = gw * 64 + lane; i < S * 32; i += NGW * 64) { const int row = i >> 5, k = i & 31;
          const float inv = exp2f(-(float)k * (13.287712379549449f / 32.0f)); const float ang = (float)p.pos[row] * inv;
          const float kq = rintf(ang * 0.15915494309189535f); float r = fmaf(-kq, 6.28125f, ang); r = fmaf(-kq, 1.9353071795864769e-3f, r);
          const float rev = r * 0.15915494309189535f; RC[i] = __builtin_amdgcn_cosf(rev); RS[i] = __builtin_amdgcn_sinf(rev); } }
    float* KM = (float*)(p.ws + WS_KMEAN);
    for (int i = gw * 64 + lane; i < 32 * D; i += NGW * 64) KM[i] = 0.f;
}

__device__ __forceinline__ void resid_phase(const Params& p, const float* hin, const float* gain, int vcu, int G, int wave, int lane) {
    const int gw = vcu * NWAVES + wave, NGW = G * NWAVES;
    const bf16_t* MIX = (const bf16_t*)(p.ws + WS_MIX); const float* SSM = (const float*)(p.ws + WS_SSM);
    bf16_t* HB = (bf16_t*)(p.ws + WS_HB); float* RSH = (float*)(p.ws + WS_RSH);
    for (int row = gw; row < S; row += NGW) {
        float sv = (lane < 32) ? SSM[(size_t)row * 32 + lane] : 0.f; sv = wave_sum(sv);
        const float rs = rsqrtf(sv * (1.0f / D) + EPS); float ss = 0.f;
#pragma unroll
        for (int j = 0; j < 4; ++j) { const int col = j * 512 + lane * 8;
            const u32x4 mw = *(const u32x4*)(MIX + (size_t)row * D + col);
            const f32x4 h0 = *(const f32x4*)(hin + (size_t)row * D + col), h1 = *(const f32x4*)(hin + (size_t)row * D + col + 4);
            const f32x4 g0 = *(const f32x4*)(gain + col), g1 = *(const f32x4*)(gain + col + 4);
            f32x4 a, b;
            a[0] = h0[0] + bflo(mw.x) * rs * g0[0]; a[1] = h0[1] + bfhi(mw.x) * rs * g0[1]; a[2] = h0[2] + bflo(mw.y) * rs * g0[2]; a[3] = h0[3] + bfhi(mw.y) * rs * g0[3];
            b[0] = h1[0] + bflo(mw.z) * rs * g1[0]; b[1] = h1[1] + bfhi(mw.z) * rs * g1[1]; b[2] = h1[2] + bflo(mw.w) * rs * g1[2]; b[3] = h1[3] + bfhi(mw.w) * rs * g1[3];
            *(f32x4*)(p.out + (size_t)row * D + col) = a; *(f32x4*)(p.out + (size_t)row * D + col + 4) = b;
            *(u32x4*)(HB + (size_t)row * D + col) = pack8s(a, b, 1.f); ss += sumsq8(a, b, 1.f); }
        ss = wave_sum(ss); if (lane == 0) RSH[row] = rsqrtf(ss * (1.0f / D) + EPS); }
}
__device__ __forceinline__ float gelu_tanh(float x) {
    const float y = 0.7978845608028654f * (x + 0.044715f * x * x * x);
    const float e = __builtin_amdgcn_exp2f(y * 2.8853900817779268f);
    const float t = 1.0f - 2.0f * __builtin_amdgcn_rcpf(1.0f + e);
    return 0.5f * x * (1.0f + t);
}
__device__ __forceinline__ void convglu_phase(const Params& p, int layer, int vcu, int G, int tid) {
    const bf16_t* U = (const bf16_t*)(p.ws + WS_U); bf16_t* ACT = (bf16_t*)(p.ws + WS_ACT);
    const float* cw = p.ffn_conv_w + (size_t)layer * 3 * FF2; const float* cb = p.ffn_conv_b + (size_t)layer * FF2;
    constexpr int NCH = FF / 8, NTASK = (S / 16) * NCH;
    for (int task = vcu * 512 + tid; task < NTASK; task += G * 512) {
        const int ch = task % NCH, strip = task / NCH, c = ch * 8, s0 = strip * 16;
        float wg[3][8], wu[3][8], bg[8], bu[8];
#pragma unroll
        for (int j = 0; j < 3; ++j) { const f32x4 a = *(const f32x4*)(cw + (size_t)j * FF2 + c), b = *(const f32x4*)(cw + (size_t)j * FF2 + c + 4), cc = *(const f32x4*)(cw + (size_t)j * FF2 + FF + c), d = *(const f32x4*)(cw + (size_t)j * FF2 + FF + c + 4);
#pragma unroll
            for (int e = 0; e < 4; ++e) { wg[j][e] = a[e]; wg[j][4 + e] = b[e]; wu[j][e] = cc[e]; wu[j][4 + e] = d[e]; } }
        { const f32x4 a = *(const f32x4*)(cb + c), b = *(const f32x4*)(cb + c + 4), cc = *(const f32x4*)(cb + FF + c), d = *(const f32x4*)(cb + FF + c + 4);
#pragma unroll
          for (int e = 0; e < 4; ++e) { bg[e] = a[e]; bg[4 + e] = b[e]; bu[e] = cc[e]; bu[4 + e] = d[e]; } }
        float g2[8], g1[8], u2[8], u1[8];
#define LD8(dst, ptr) do { const u32x4 w_ = *(const u32x4*)(ptr); dst[0] = bflo(w_.x); dst[1] = bfhi(w_.x); dst[2] = bflo(w_.y); dst[3] = bfhi(w_.y); dst[4] = bflo(w_.z); dst[5] = bfhi(w_.z); dst[6] = bflo(w_.w); dst[7] = bfhi(w_.w); } while (0)
        if (s0 >= 2) { LD8(g2, U + (size_t)(s0 - 2) * FF2 + c); LD8(g1, U + (size_t)(s0 - 1) * FF2 + c); LD8(u2, U + (size_t)(s0 - 2) * FF2 + FF + c); LD8(u1, U + (size_t)(s0 - 1) * FF2 + FF + c); }
        else {
#pragma unroll
            for (int e = 0; e < 8; ++e) { g2[e] = 0.f; g1[e] = 0.f; u2[e] = 0.f; u1[e] = 0.f; } }
#pragma unroll 4
        for (int r = 0; r < 16; ++r) { float g0[8], u0[8]; LD8(g0, U + (size_t)(s0 + r) * FF2 + c); LD8(u0, U + (size_t)(s0 + r) * FF2 + FF + c);
            float o[8];
#pragma unroll
            for (int e = 0; e < 8; ++e) { const float gt = wg[0][e] * g2[e] + wg[1][e] * g1[e] + wg[2][e] * g0[e] + bg[e]; const float up = wu[0][e] * u2[e] + wu[1][e] * u1[e] + wu[2][e] * u0[e] + bu[e];
                o[e] = gelu_tanh(gt) * up; g2[e] = g1[e]; g1[e] = g0[e]; u2[e] = u1[e]; u1[e] = u0[e]; }
            u32x4 w; w.x = cvt_pk_bf16(o[0], o[1]); w.y = cvt_pk_bf16(o[2], o[3]); w.z = cvt_pk_bf16(o[4], o[5]); w.w = cvt_pk_bf16(o[6], o[7]);
            *(u32x4*)(ACT + (size_t)(s0 + r) * FF + c) = w; }
#undef LD8
    }
}
__device__ __forceinline__ void gate_phase(const Params& p, LAS unsigned char* lds, int vcu, int G, int tid) {
    const bf16_t* Q = (const bf16_t*)(p.ws + WS_Q); const float* KM = (const float*)(p.ws + WS_KMEAN); unsigned* SEL = (unsigned*)(p.ws + WS_SEL);
    LAS float* km = (LAS float*)lds;
    for (int unit = vcu; unit < NH * 16; unit += G) {
        const int h = unit >> 4, qc = unit & 15;
        __syncthreads();
        for (int i = tid; i < 32 * 128; i += 512) km[i] = KM[(size_t)(i >> 7) * D + h * 128 + (i & 127)] * (1.0f / 256.0f);
        __syncthreads();
        const int q = qc * 512 + tid, own = q >> 8;
        float acc[32];
#pragma unroll
        for (int g = 0; g < 4; ++g) { float a8[8];
#pragma unroll
            for (int j = 0; j < 8; ++j) a8[j] = 0.f;
#pragma unroll 1
            for (int d = 0; d < 128; d += 8) { const u32x4 qw = *(const u32x4*)(Q + (size_t)q * D + h * 128 + d);
                const float q0 = bflo(qw.x), q1 = bfhi(qw.x), q2 = bflo(qw.y), q3 = bfhi(qw.y), q4 = bflo(qw.z), q5 = bfhi(qw.z), q6 = bflo(qw.w), q7 = bfhi(qw.w);
#pragma unroll
                for (int j = 0; j < 8; ++j) { const f32x4 k0 = *(const LAS f32x4*)(km + (g * 8 + j) * 128 + d), k1 = *(const LAS f32x4*)(km + (g * 8 + j) * 128 + d + 4);
                    a8[j] += (q0 * k0[0] + q1 * k0[1]) + (q2 * k0[2] + q3 * k0[3]) + (q4 * k1[0] + q5 * k1[1]) + (q6 * k1[2] + q7 * k1[3]); } }
#pragma unroll
            for (int j = 0; j < 8; ++j) acc[g * 8 + j] = a8[j]; }
        unsigned mask = 0u; const int cnt = own < 3 ? own : 3;
#pragma unroll
        for (int k = 0; k < 3; ++k) { if (k < cnt) { float best = -__builtin_inff(); int bi = 0;
#pragma unroll
                for (int n = 0; n < 32; ++n) { const bool ok = (n < own) && !((mask >> n) & 1u) && (acc[n] > best); if (ok) { best = acc[n]; bi = n; } }
                mask |= 1u << bi; } }
        SEL[(size_t)q * NH + h] = mask | (1u << own);
    }
}

__global__ void __launch_bounds__(NWAVES * 64, 2) fwd_kernel(Params p) {
    extern __shared__ __attribute__((aligned(16))) unsigned char lds_raw[];
    LAS unsigned char* lds = (LAS unsigned char*)lds_raw;
    const int tid = threadIdx.x, lane = tid & 63, wave = __builtin_amdgcn_readfirstlane(tid >> 6);
    const int G = gridDim.x; const int bx = blockIdx.x; const int vcu = (G % 8 == 0) ? (bx % 8) * (G / 8) + bx / 8 : bx;
    volatile LAS unsigned* MISC = (volatile LAS unsigned*)(lds + MISC_OFF);
    for (int u = tid; u < (LDS_BYTES - LDSCTL_OFF) / 4; u += NWAVES * 64) ((LAS unsigned*)(lds + LDSCTL_OFF))[u] = 0u;
    __syncthreads();
    unsigned* ctl = (unsigned*)(p.ws + WS_CTL);
    XcdBarrier bar; bar.bar = ctl + CW_BAR; bar.x = 0; bar.st = nullptr;
    const bool one_launch = (p.ph_hi - p.ph_lo) > 1;
    if (one_launch) bar = xcd_barrier_post(ctl + CW_BAR, MISC + 8);
    const int lo = p.ph_lo, hi = p.ph_hi;
    int ph = 0;
#define IN() (lo <= ph && ph < hi)
#define SEAM() do { if (ph + 1 < hi) xcd_barrier(bar); } while (0)

    bf16_t* HB = (bf16_t*)(p.ws + WS_HB); float* RSH = (float*)(p.ws + WS_RSH);
    bf16_t* CQ = (bf16_t*)(p.ws + WS_CQ); bf16_t* CKV = (bf16_t*)(p.ws + WS_CKV); bf16_t* KROPE = (bf16_t*)(p.ws + WS_KROPE); float* SSQ = (float*)(p.ws + WS_SSQ);
    bf16_t* Qb = (bf16_t*)(p.ws + WS_Q); bf16_t* KN = (bf16_t*)(p.ws + WS_KN); bf16_t* Vb = (bf16_t*)(p.ws + WS_V);
    bf16_t* KB = (bf16_t*)(p.ws + WS_KB); bf16_t* VB = (bf16_t*)(p.ws + WS_VB); float* KMEAN = (float*)(p.ws + WS_KMEAN);
    bf16_t* Ob = (bf16_t*)(p.ws + WS_O); bf16_t* MIX = (bf16_t*)(p.ws + WS_MIX); float* SSM = (float*)(p.ws + WS_SSM);
    bf16_t* Ub = (bf16_t*)(p.ws + WS_U); bf16_t* ACT = (bf16_t*)(p.ws + WS_ACT);
    const float* RCOS = (const float*)(p.ws + WS_RCOS); const float* RSIN = (const float*)(p.ws + WS_RSIN);

    if (SITE(0) && IN()) { { const int t_ = opaque_tid(); prologue_phase(p, lds, vcu, G, __builtin_amdgcn_readfirstlane(t_ >> 6), t_ & 63); } SEAM(); } ++ph;

    for (int layer = 0; layer < NLAYER; ++layer) {
        if (layer < 2) {
            if (SITE(1) && IN()) { pg8::Sched Sc; Sc.init(S, D, HB, (const bf16_t*)(p.ws + WS_WIN) + (size_t)layer * NINP * D, NINP, nullptr, nullptr, 0, G, bx);
                EpiMlaIn E{CQ, CKV, KROPE, SSQ, RSH, RCOS, RSIN};
                pg8::gemm_phase<EpiMlaIn, true, true>(lds, D, Sc, E); SEAM(); } ++ph;
            if (SITE(2) && IN()) { const bf16_t* W = (const bf16_t*)(p.ws + WS_WUPG) + (size_t)layer * 7168 * 512;
                pg8::Sched Sc; Sc.init(S, 512, CQ, W, NQUP, CKV, W + (size_t)NQUP * 512, NKVUP, G, bx);
                EpiMlaUp E{Qb, KN, Vb, SSQ, RCOS, RSIN};
                pg8::gemm_phase<EpiMlaUp, true, true>(lds, 512, Sc, E); SEAM(); } ++ph;
            if (SITE(3) && IN()) { att::Args T{Qb, KN, KROPE, Vb, Ob, nullptr, nullptr, p.pos};
                for (int it = vcu; it < NH * 16; it += G) { const int h = it >> 4, y = it & 15;
                    att::attn_unit<false>(lds, T, h, y); att::attn_unit<false>(lds, T, h, 31 - y); }
                SEAM(); } ++ph;
        } else {
            if (SITE(4) && IN()) { const bool first = (layer == 2);
                pg8::Sched Sc; Sc.init(S, D, HB, first ? (const bf16_t*)(p.ws + WS_WKVQ) : (const bf16_t*)(p.ws + WS_WQ1), first ? 6144 : 2048, nullptr, nullptr, 0, G, bx);
                EpiMobaKvq E{p.ws, KMEAN, RSH, first ? 0 : 16};
                pg8::gemm_phase<EpiMobaKvq, true, true>(lds, D, Sc, E); SEAM(); } ++ph;
            if (SITE(5) && IN()) { gate_phase(p, lds, vcu, G, opaque_tid()); SEAM(); } ++ph;
            if (SITE(6) && IN()) { att::Args T{Qb, KB, nullptr, VB, Ob, (const unsigned*)(p.ws + WS_SEL), p.rel_bias, p.pos};
                for (int it = vcu; it < NH * 16; it += G) { const int h = it >> 4, y = it & 15;
                    att::attn_unit<true>(lds, T, h, y); att::attn_unit<true>(lds, T, h, 31 - y); }
                SEAM(); } ++ph;
        }
        if (SITE(7) && IN()) { pg8::Sched Sc; Sc.init(S, D, Ob, (const bf16_t*)(p.ws + WS_WO) + (size_t)layer * D * D, D, nullptr, nullptr, 0, G, bx);
            EpiMix E{MIX, SSM};
            pg8::gemm_phase<EpiMix, false, true>(lds, D, Sc, E); SEAM(); } ++ph;
        if (SITE(8) && IN()) { { const int t_ = opaque_tid(); resid_phase(p, layer == 0 ? p.x : p.out, p.gains + (size_t)(layer * 4 + 1) * D, vcu, G, __builtin_amdgcn_readfirstlane(t_ >> 6), t_ & 63); } SEAM(); } ++ph;
        if (SITE(9) && IN()) { pg8::Sched Sc; Sc.init(S, D, HB, (const bf16_t*)(p.ws + WS_WUP) + (size_t)layer * FF2 * D, FF2, nullptr, nullptr, 0, G, bx);
            EpiFfnUp E{Ub, RSH};
            pg8::gemm_phase<EpiFfnUp, true, true>(lds, D, Sc, E); SEAM(); } ++ph;
        if (SITE(10) && IN()) { convglu_phase(p, layer, vcu, G, opaque_tid()); SEAM(); } ++ph;
        if (SITE(11) && IN()) { pg8::Sched Sc; Sc.init(S, FF, ACT, (const bf16_t*)(p.ws + WS_WDN) + (size_t)layer * D * FF, D, nullptr, nullptr, 0, G, bx);
            EpiMix E{MIX, SSM};
            pg8::gemm_phase<EpiMix, false, true>(lds, FF, Sc, E); SEAM(); } ++ph;
        if (SITE(12) && IN()) { { const int t_ = opaque_tid(); resid_phase(p, p.out, p.gains + (size_t)(layer * 4 + 3) * D, vcu, G, __builtin_amdgcn_readfirstlane(t_ >> 6), t_ & 63); } SEAM(); } ++ph;
    }
#undef IN
#undef SEAM
}

extern "C" void kernel_launch(void* const* d_in, const int* in_sizes, int n_in, void* d_out, int out_size, void* d_ws, size_t ws_size, hipStream_t stream) {
    static int grid = 0;
    if (grid == 0) {
        if (n_in != 18 || in_sizes[0] != S * D || out_size != S * D || ws_size < WS_END) { fprintf(stderr, "kernel_launch: unexpected shapes (n_in %d, in0 %d, out %d, ws %zu)\n", n_in, n_in > 0 ? in_sizes[0] : -1, out_size, ws_size); grid = -1; return; }
        int dev = 0, cus = 0, per_cu = 0;
        if (hipGetDevice(&dev) != hipSuccess || hipDeviceGetAttribute(&cus, hipDeviceAttributeMultiprocessorCount, dev) != hipSuccess) { grid = -1; return; }
        if (hipFuncSetAttribute((const void*)fwd_kernel, hipFuncAttributeMaxDynamicSharedMemorySize, LDS_BYTES) != hipSuccess) { fprintf(stderr, "kernel_launch: hipFuncSetAttribute failed\n"); grid = -1; return; }
        if (hipOccupancyMaxActiveBlocksPerMultiprocessor(&per_cu, (const void*)fwd_kernel, NWAVES * 64, LDS_BYTES) != hipSuccess || per_cu < 1) fprintf(stderr, "kernel_launch: occupancy query reports %d\n", per_cu);
        (void)hipGetLastError();
        grid = cus;
    }
    if (grid < 0) return;
    (void)hipMemsetAsync((char*)d_ws + WS_CTL, 0, CTL_ZERO_BYTES, stream);
    Params p{};
    p.x = (const float*)d_in[0]; p.pos = (const int*)d_in[1]; p.gains = (const float*)d_in[2]; p.a_w_in = (const float*)d_in[3]; p.a_q_norm = (const float*)d_in[4];
    p.a_w_q_up = (const float*)d_in[5]; p.a_kv_norm = (const float*)d_in[6]; p.a_w_kv_up = (const float*)d_in[7]; p.a_w_o = (const float*)d_in[8]; p.b_kv_norm = (const float*)d_in[9];
    p.b_w_kv = (const float*)d_in[10]; p.b_w_q = (const float*)d_in[11]; p.b_w_o = (const float*)d_in[12]; p.rel_bias = (const float*)d_in[13]; p.ffn_w_in = (const float*)d_in[14];
    p.ffn_conv_w = (const float*)d_in[15]; p.ffn_conv_b = (const float*)d_in[16]; p.ffn_w_out = (const float*)d_in[17]; p.out = (float*)d_out; p.ws = (unsigned char*)d_ws;
#if MK_ONE_LAUNCH
    p.ph_lo = 0; p.ph_hi = NPHASE;
    hipLaunchKernelGGL(fwd_kernel, dim3(grid), dim3(NWAVES * 64), LDS_BYTES, stream, p);
#else
    for (int ph = 0; ph < NPHASE; ++ph) { p.ph_lo = ph; p.ph_hi = ph + 1;
        hipLaunchKernelGGL(fwd_kernel, dim3(grid), dim3(NWAVES * 64), LDS_BYTES, stream, p); }
#endif
}
```

```cpp
#include <hip/hip_runtime.h>
#include <cstdio>
#include <cstdint>

#ifndef MK_ONE_LAUNCH
#define MK_ONE_LAUNCH 1
#endif

#ifndef SITE_MASK
#define SITE_MASK 0xFFFF
#endif
#define SITE(n) (((SITE_MASK) >> (n)) & 1)
#define LAS __attribute__((address_space(3)))
#define GAS __attribute__((address_space(1)))
typedef unsigned short bf16_t;
typedef short bf16x8 __attribute__((ext_vector_type(8)));
typedef short s16x4 __attribute__((ext_vector_type(4)));
typedef float f32x2 __attribute__((ext_vector_type(2)));
typedef float f32x4 __attribute__((ext_vector_type(4)));
typedef float f32x16 __attribute__((ext_vector_type(16)));
typedef unsigned u32x2 __attribute__((ext_vector_type(2)));
typedef unsigned u32x4 __attribute__((ext_vector_type(4)));
typedef int i32x4 __attribute__((ext_vector_type(4)));
typedef GAS unsigned gu32;

constexpr int S = 8192, D = 2048, NH = 16, FF = 5632, FF2 = 11264;
constexpr int QL = 512, KVL = 512, DQK = 192;
constexpr int NIN = 1088, NINP = 1280;
constexpr int NQUP = NH * DQK, NKVUP = NH * 256;
constexpr int NLAYER = 4;
constexpr float EPS = 1e-6f;
constexpr int NPHASE = 1 + NLAYER * 9;

constexpr size_t MiB = 1u << 20;
constexpr size_t WS_CTL = 0, CTL_ZERO_BYTES = 1 * MiB;
constexpr size_t WS_WIN = 2 * MiB;
constexpr size_t WS_WUPG = 12 * MiB;
constexpr size_t WS_WO = 26 * MiB;
constexpr size_t WS_WKVQ = 58 * MiB;
constexpr size_t WS_WQ1 = 82 * MiB;
constexpr size_t WS_WUP = 90 * MiB;
constexpr size_t WS_WDN = 266 * MiB;
constexpr size_t WS_HB = 354 * MiB;
constexpr size_t WS_RSH = 386 * MiB;
constexpr size_t WS_CQ = 387 * MiB;
constexpr size_t WS_CKV = 395 * MiB;
constexpr size_t WS_KROPE = 403 * MiB;
constexpr size_t WS_SSQ = 404 * MiB;
constexpr size_t WS_Q = 405 * MiB;
constexpr size_t WS_KN = 453 * MiB;
constexpr size_t WS_V = 485 * MiB;
constexpr size_t WS_KB = 517 * MiB;
constexpr size_t WS_VB = 549 * MiB;
constexpr size_t WS_KMEAN = 581 * MiB;
constexpr size_t WS_SEL = 582 * MiB;
constexpr size_t WS_O = 583 * MiB;
constexpr size_t WS_MIX = 615 * MiB;
constexpr size_t WS_SSM = 647 * MiB;
constexpr size_t WS_U = 648 * MiB;
constexpr size_t WS_ACT = 824 * MiB;
constexpr size_t WS_RCOS = 912 * MiB;
constexpr size_t WS_RSIN = 913 * MiB;
constexpr size_t WS_END = 914 * MiB;

constexpr int CW_BAR = 4096;

constexpr int RING_BYTES = 131072;
constexpr int LDSCTL_OFF = RING_BYTES, MISC_OFF = LDSCTL_OFF + 320;
constexpr int LDS_BYTES = 147456;
constexpr int NWAVES = 8;

#define LDS_WAIT() asm volatile("s_waitcnt lgkmcnt(0)" ::: "memory")
#define VM_WAIT() asm volatile("s_waitcnt vmcnt(0)" ::: "memory")
#define SBAR() __builtin_amdgcn_sched_barrier(0)

__device__ __forceinline__ int opaque_tid() { int t = threadIdx.x; asm volatile("" : "+v"(t)); return t; }
__device__ __forceinline__ unsigned cvt_pk_bf16(float lo, float hi) { unsigned r; asm volatile("v_cvt_pk_bf16_f32 %0, %1, %2" : "=v"(r) : "v"(lo), "v"(hi)); return r; }
__device__ __forceinline__ float bf2f(unsigned short b) { return __uint_as_float(((unsigned)b) << 16); }
__device__ __forceinline__ float bflo(unsigned w) { return __uint_as_float(w << 16); }
__device__ __forceinline__ float bfhi(unsigned w) { return __uint_as_float(w & 0xffff0000u); }
__device__ __forceinline__ float wave_sum(float v) {
#pragma unroll
    for (int o = 1; o < 64; o <<= 1) v += __shfl_xor(v, o);
    return v;
}

namespace pg8 {
constexpr int BM = 256, BK = 64, HALF = 128, HTB = HALF * BK * 2, STAGE_BYTES = 8 * HTB, NXCD = 8, WGM = 8;
__host__ __device__ __forceinline__ int lds_byte(int r, int c) { const int st = (r >> 4) * 2 + (c >> 5), rr = r & 15, cc = c & 31, ob = rr * 64 + cc * 2; return st * 1024 + (ob ^ (((ob >> 9) & 1) << 5)); }
__host__ __device__ __forceinline__ void stage_rc(int b, int& R, int& C) { const int st = b / 1024, sb = b % 1024, swz = sb ^ (((sb >> 9) & 1) << 5); R = (st >> 1) * 16 + swz / 64; C = (st & 1) * 32 + (swz % 64) / 2; }
__host__ __device__ __forceinline__ int perm32(int rho) { const int n = rho >> 4, i = rho & 15; return 8 * (i >> 2) + 4 * n + (i & 3); }

struct Unit { int pm, pn, gi; };

struct Sched {
    int nM, nN0, nwg0, nN1, nwg1, G, c;
    const char* A0; const char* B0; const char* A1; const char* B1; size_t tstep;
    __device__ __forceinline__ void init(int M, int K, const bf16_t* a0, const bf16_t* b0, int N0, const bf16_t* a1, const bf16_t* b1, int N1, int G_, int c_) {
        nM = M / BM; nN0 = N0 / BM; nwg0 = nM * nN0; nN1 = N1 / BM; nwg1 = nM * nN1; G = G_; c = c_;
        A0 = (const char*)a0; B0 = (const char*)b0; A1 = (const char*)a1; B1 = (const char*)b1; tstep = (size_t)BM * K * 2;
    }
    __device__ __forceinline__ void map(int wgid, int nwg, int nN, Unit& u) const {
        { const int q = nwg / NXCD, r = nwg % NXCD, xcd = wgid % NXCD, off = wgid / NXCD; wgid = (xcd < r ? xcd * (q + 1) : r * (q + 1) + (xcd - r) * q) + off; }
        const int nig = WGM * nN, gid = wgid / nig, fm = gid * WGM, gsz = (nM - fm) < WGM ? (nM - fm) : WGM;
        u.pm = fm + ((wgid % nig) % gsz); u.pn = (wgid % nig) / gsz;
    }
    __device__ __forceinline__ bool next(int i, Unit& u) const {
        const long L = (long)i * G + c;
        if (L < nwg0) { u.gi = 0; map((int)L, nwg0, nN0, u); return true; }
        if (L < nwg0 + nwg1) { u.gi = 1; map((int)(L - nwg0), nwg1, nN1, u); return true; }
        return false;
    }
    __device__ __forceinline__ const char* aptr(const Unit& u) const { return (u.gi ? A1 : A0) + (size_t)u.pm * tstep; }
    __device__ __forceinline__ const char* bptr(const Unit& u) const { return (u.gi ? B1 : B0) + (size_t)u.pn * tstep; }
};

template <class Epi, bool ALIGN_EPI, bool SP2>
__device__ __forceinline__ void gemm_phase(LAS unsigned char* lds, const int K, const Sched& S, const Epi& E) {
    const int tid = opaque_tid(), wid = __builtin_amdgcn_readfirstlane(tid >> 6), lane = tid & 63, wr = wid >> 2, wc = wid & 3, fr = lane & 15, fq = lane >> 4;
    const int nt = K / BK;
    unsigned voffA[2], voffB[2];
#pragma unroll
    for (int i = 0; i < 2; ++i) { int R, C; stage_rc(tid * 16 + i * 8192, R, C); const int Rb = Epi::PERM ? ((R & ~31) + perm32(R & 31)) : R;
        voffA[i] = (unsigned)(R * K + C) * 2u; voffB[i] = (unsigned)(Rb * K + C) * 2u; }
    const size_t kstep = (size_t)(BK * 2);
    const size_t hstep = (size_t)HALF * K * 2;
    const unsigned ldsw = (unsigned)wid * 1024u;
    const int aoff = lds_byte(wr * 64 + fr, fq * 8), boff = lds_byte(wc * 32 + fr, fq * 8);
#define PG8_SA(b, h) (((b) * 2 + (h)) * HTB)
#define PG8_SB(b, h) ((4 + (b) * 2 + (h)) * HTB)
#define PG8_STAGE(bufoff, gbase, voff) do { _Pragma("unroll") for (int _i = 0; _i < 2; ++_i) \
        __builtin_amdgcn_global_load_lds((const unsigned*)((const char*)(gbase) + (voff)[_i]), (LAS unsigned*)(lds + (bufoff) + ldsw + _i * 8192), 16, 0, 0); } while (0)
#define PG8_LDA(dst, b, h) do { _Pragma("unroll") for (int m = 0; m < 4; ++m) _Pragma("unroll") for (int k = 0; k < 2; ++k) dst[m][k] = *(const LAS bf16x8*)(lds + PG8_SA(b, h) + aoff + m * 2048 + k * 1024); } while (0)
#define PG8_LDB(dst, b, h) do { _Pragma("unroll") for (int n = 0; n < 2; ++n) _Pragma("unroll") for (int k = 0; k < 2; ++k) dst[n][k] = *(const LAS bf16x8*)(lds + PG8_SB(b, h) + boff + n * 2048 + k * 1024); } while (0)
#define PG8_MMA(ai, bj, At, Bt) do { __builtin_amdgcn_s_setprio(1); _Pragma("unroll") for (int m = 0; m < 4; ++m) _Pragma("unroll") for (int n = 0; n < 2; ++n) _Pragma("unroll") for (int k = 0; k < 2; ++k) \
        acc[ai][bj][m][n] = __builtin_amdgcn_mfma_f32_16x16x32_bf16(Bt[n][k], At[m][k], acc[ai][bj][m][n], 0, 0, 0); __builtin_amdgcn_s_setprio(0); } while (0)
#define PG8_WAIT_V(n) asm volatile("s_waitcnt vmcnt(" #n ")" ::: "memory")
#define PG8_WAIT_L(n) asm volatile("s_waitcnt lgkmcnt(" #n ")" ::: "memory")
#define PG8_BAR __builtin_amdgcn_s_barrier()
#define PG8_SCHED __builtin_amdgcn_sched_barrier(0)
    Unit cur, nxt; int ui = 0;
    if (!S.next(0, cur)) return;
    f32x4 acc[2][2][4][2];
#pragma unroll
    for (int a = 0; a < 2; ++a)
#pragma unroll
        for (int b = 0; b < 2; ++b)
#pragma unroll
            for (int m = 0; m < 4; ++m)
#pragma unroll
                for (int n = 0; n < 2; ++n) acc[a][b][m][n] = (f32x4){0.f, 0.f, 0.f, 0.f};
    bf16x8 At[4][2], B0[2][2], B1[2][2];
    const char* cA = S.aptr(cur); const char* cB = S.bptr(cur);
    if constexpr (SP2) {
        PG8_STAGE(PG8_SB(0, 0), cB, voffB); PG8_STAGE(PG8_SB(0, 1), cB + hstep, voffB); PG8_STAGE(PG8_SA(0, 0), cA, voffA); PG8_STAGE(PG8_SA(0, 1), cA + hstep, voffA);
        if (wr == 1) PG8_BAR;
        PG8_WAIT_V(2); PG8_BAR;
        PG8_STAGE(PG8_SB(1, 0), cB + kstep, voffB); PG8_STAGE(PG8_SA(1, 0), cA + kstep, voffA); PG8_STAGE(PG8_SB(1, 1), cB + hstep + kstep, voffB);
        PG8_WAIT_V(6); PG8_BAR;
    } else {
        PG8_STAGE(PG8_SB(0, 0), cB, voffB); PG8_STAGE(PG8_SA(0, 0), cA, voffA); PG8_STAGE(PG8_SB(0, 1), cB + hstep, voffB); PG8_STAGE(PG8_SA(0, 1), cA + hstep, voffA);
        if (wr == 1) PG8_BAR;
        PG8_WAIT_V(4); PG8_BAR;
        PG8_STAGE(PG8_SB(1, 0), cB + kstep, voffB); PG8_STAGE(PG8_SA(1, 0), cA + kstep, voffA); PG8_STAGE(PG8_SB(1, 1), cB + hstep + kstep, voffB);
        PG8_WAIT_V(6); PG8_BAR;
    }
    for (;;) {
        const bool has_next = S.next(ui + 1, nxt);
        const char* nA = has_next ? S.aptr(nxt) : cA; const char* nB = has_next ? S.bptr(nxt) : cB;
        for (int t = 0; t < nt; t += 2) {
            const bool last = (t == nt - 2);
            const char* a1 = cA + (size_t)(t + 1) * kstep;
            const char* a2 = last ? nA : cA + (size_t)(t + 2) * kstep; const char* b2 = last ? nB : cB + (size_t)(t + 2) * kstep;
            const char* a3 = a2 + kstep; const char* b3 = b2 + kstep;
            if constexpr (SP2) {
            PG8_LDB(B0, 0, 0); PG8_LDB(B1, 0, 1); PG8_SCHED; PG8_LDA(At, 0, 0); PG8_STAGE(PG8_SA(1, 1), a1 + hstep, voffA);
            PG8_WAIT_V(8); PG8_WAIT_L(0); PG8_BAR; PG8_MMA(0, 0, At, B0); PG8_MMA(0, 1, At, B1); PG8_BAR; PG8_SCHED;
            PG8_LDA(At, 0, 1); PG8_STAGE(PG8_SB(0, 0), b2, voffB); PG8_STAGE(PG8_SB(0, 1), b2 + hstep, voffB); PG8_STAGE(PG8_SA(0, 0), a2, voffA);
            PG8_WAIT_V(8); PG8_WAIT_L(0); PG8_BAR; PG8_MMA(1, 0, At, B0); PG8_MMA(1, 1, At, B1); PG8_BAR; PG8_SCHED;
            PG8_LDB(B0, 1, 0); PG8_LDB(B1, 1, 1); PG8_SCHED; PG8_LDA(At, 1, 0); PG8_STAGE(PG8_SA(0, 1), a2 + hstep, voffA);
            PG8_WAIT_V(8); PG8_WAIT_L(0); PG8_BAR; PG8_MMA(0, 0, At, B0); PG8_MMA(0, 1, At, B1); PG8_BAR; PG8_SCHED;
            PG8_LDA(At, 1, 1); PG8_STAGE(PG8_SB(1, 0), b3, voffB); PG8_STAGE(PG8_SB(1, 1), b3 + hstep, voffB); PG8_STAGE(PG8_SA(1, 0), a3, voffA);
            PG8_WAIT_V(8); PG8_WAIT_L(0); PG8_BAR; PG8_MMA(1, 0, At, B0); PG8_MMA(1, 1, At, B1); PG8_BAR; PG8_SCHED;
            } else {
            PG8_LDB(B0, 0, 0); PG8_SCHED; PG8_LDA(At, 0, 0); PG8_STAGE(PG8_SA(1, 1), a1 + hstep, voffA);
            PG8_WAIT_L(8); PG8_BAR; PG8_WAIT_L(0); PG8_MMA(0, 0, At, B0); PG8_BAR; PG8_SCHED;
            PG8_LDB(B1, 0, 1); PG8_STAGE(PG8_SB(0, 0), b2, voffB);
            PG8_BAR; PG8_WAIT_L(0); PG8_MMA(0, 1, At, B1); PG8_BAR;
            PG8_LDA(At, 0, 1); PG8_STAGE(PG8_SA(0, 0), a2, voffA);
            PG8_BAR; PG8_WAIT_L(0); PG8_MMA(1, 0, At, B0); PG8_BAR; PG8_SCHED;
            PG8_STAGE(PG8_SB(0, 1), b2 + hstep, voffB);
            PG8_WAIT_V(6); PG8_BAR; PG8_MMA(1, 1, At, B1); PG8_BAR;
            PG8_LDB(B0, 1, 0); PG8_SCHED; PG8_LDA(At, 1, 0); PG8_STAGE(PG8_SA(0, 1), a2 + hstep, voffA);
            PG8_WAIT_L(8); PG8_BAR; PG8_WAIT_L(0); PG8_MMA(0, 0, At, B0); PG8_BAR; PG8_SCHED;
            PG8_LDB(B1, 1, 1); PG8_STAGE(PG8_SB(1, 0), b3, voffB);
            PG8_BAR; PG8_WAIT_L(0); PG8_MMA(0, 1, At, B1); PG8_BAR;
            PG8_LDA(At, 1, 1); PG8_STAGE(PG8_SA(1, 0), a3, voffA);
            PG8_BAR; PG8_WAIT_L(0); PG8_MMA(1, 0, At, B0); PG8_BAR; PG8_SCHED;
            PG8_STAGE(PG8_SB(1, 1), b3 + hstep, voffB);
            PG8_WAIT_V(6); PG8_BAR; PG8_MMA(1, 1, At, B1); PG8_BAR;
            }
        }
        if constexpr (ALIGN_EPI) { if (wr == 0) PG8_BAR; }
        E(acc, cur, wr, wc, fr, fq);
        if (!has_next) break;
#pragma unroll
        for (int a = 0; a < 2; ++a)
#pragma unroll
            for (int b = 0; b < 2; ++b)
#pragma unroll
                for (int m = 0; m < 4; ++m)
#pragma unroll
                    for (int n = 0; n < 2; ++n) acc[a][b][m][n] = (f32x4){0.f, 0.f, 0.f, 0.f};
        cur = nxt; cA = nA; cB = nB; ++ui;
        if constexpr (ALIGN_EPI) { if (wr == 1) PG8_BAR; }
    }
    PG8_WAIT_V(0);
    if constexpr (!ALIGN_EPI) { if (wr == 0) PG8_BAR; }
    PG8_BAR;
#undef PG8_SA
#undef PG8_SB
#undef PG8_STAGE
#undef PG8_LDA
#undef PG8_LDB
#undef PG8_MMA
#undef PG8_WAIT_V
#undef PG8_WAIT_L
#undef PG8_BAR
#undef PG8_SCHED
}
}

#define EPI_ROWS_BEGIN() const int row0 = u.pm * 256 + wr * 64 + fr; const int cl0 = wc * 32 + 8 * fq;
__device__ __forceinline__ u32x4 pack8s(f32x4 a, f32x4 b, float s) {
    u32x4 w; w.x = cvt_pk_bf16(a[0] * s, a[1] * s); w.y = cvt_pk_bf16(a[2] * s, a[3] * s); w.z = cvt_pk_bf16(b[0] * s, b[1] * s); w.w = cvt_pk_bf16(b[2] * s, b[3] * s); return w;
}
__device__ __forceinline__ float sumsq8(f32x4 a, f32x4 b, float s) {
    a = a * s; b = b * s; return (a[0] * a[0] + a[1] * a[1]) + (a[2] * a[2] + a[3] * a[3]) + (b[0] * b[0] + b[1] * b[1]) + (b[2] * b[2] + b[3] * b[3]);
}
__device__ __forceinline__ void rope8(f32x4& a, f32x4& b, const float* ctab, const float* stab, int row, int i0) {
    const f32x4 cs = *(const f32x4*)(ctab + (size_t)row * 32 + i0), sn = *(const f32x4*)(stab + (size_t)row * 32 + i0);
    const f32x4 a2 = (f32x4){a[0] * cs[0] - a[1] * sn[0], a[0] * sn[0] + a[1] * cs[0], a[2] * cs[1] - a[3] * sn[1], a[2] * sn[1] + a[3] * cs[1]};
    const f32x4 b2 = (f32x4){b[0] * cs[2] - b[1] * sn[2], b[0] * sn[2] + b[1] * cs[2], b[2] * cs[3] - b[3] * sn[3], b[2] * sn[3] + b[3] * cs[3]};
    a = a2; b = b2;
}

struct EpiMlaIn {
    static constexpr bool PERM = true;
    bf16_t* CQ; bf16_t* CKV; bf16_t* KR; float* SSQ; const float* rsh; const float* ctab; const float* stab;
    __device__ __forceinline__ void operator()(const f32x4 (&acc)[2][2][4][2], const pg8::Unit& u, int wr, int wc, int fr, int fq) const {
        EPI_ROWS_BEGIN();
        if (u.pn < 4) {
            bf16_t* base = (u.pn < 2 ? CQ : CKV) + (u.pn & 1) * 256;
#pragma unroll
            for (int ai = 0; ai < 2; ++ai)
#pragma unroll
                for (int m = 0; m < 4; ++m) { const int row = row0 + ai * 128 + m * 16; const float rs = rsh[row]; float ss = 0.f;
#pragma unroll
                    for (int bj = 0; bj < 2; ++bj) { *(u32x4*)(base + (size_t)row * 512 + bj * 128 + cl0) = pack8s(acc[ai][bj][m][0], acc[ai][bj][m][1], rs); ss += sumsq8(acc[ai][bj][m][0], acc[ai][bj][m][1], rs); }
                    ss += __shfl_xor(ss, 16); ss += __shfl_xor(ss, 32);
                    if (fq == 0) SSQ[(size_t)row * 16 + (u.pn >> 1) * 8 + (u.pn & 1) * 4 + wc] = ss; }
        } else if (wc < 2) {
#pragma unroll
            for (int ai = 0; ai < 2; ++ai)
#pragma unroll
                for (int m = 0; m < 4; ++m) { const int row = row0 + ai * 128 + m * 16; const float rs = rsh[row];
                    f32x4 a = acc[ai][0][m][0] * rs, b = acc[ai][0][m][1] * rs; rope8(a, b, ctab, stab, row, cl0 >> 1);
                    *(u32x4*)(KR + (size_t)row * 64 + cl0) = pack8s(a, b, 1.f); }
        }
    }
};
struct EpiMlaUp {
    static constexpr bool PERM = true;
    bf16_t* Q; bf16_t* KN; bf16_t* V; const float* SSQ; const float* ctab; const float* stab;
    __device__ __forceinline__ void operator()(const f32x4 (&acc)[2][2][4][2], const pg8::Unit& u, int wr, int wc, int fr, int fq) const {
        EPI_ROWS_BEGIN();
#pragma unroll
        for (int ai = 0; ai < 2; ++ai)
#pragma unroll
            for (int m = 0; m < 4; ++m) { const int row = row0 + ai * 128 + m * 16;
                const f32x4 s0 = *(const f32x4*)(SSQ + (size_t)row * 16 + u.gi * 8), s1 = *(const f32x4*)(SSQ + (size_t)row * 16 + u.gi * 8 + 4);
                const float ss = ((s0[0] + s0[1]) + (s0[2] + s0[3])) + ((s1[0] + s1[1]) + (s1[2] + s1[3]));
                const float rs = rsqrtf(ss * (1.0f / 512.0f) + EPS);
                if (u.gi == 0) {
#pragma unroll
                    for (int bj = 0; bj < 2; ++bj) { const int col = u.pn * 256 + bj * 128 + cl0; const int w = col % DQK;
                        f32x4 a = acc[ai][bj][m][0] * rs, b = acc[ai][bj][m][1] * rs;
                        if (w >= 128) rope8(a, b, ctab, stab, row, (w - 128) >> 1);
                        *(u32x4*)(Q + (size_t)row * NQUP + col) = pack8s(a, b, 1.f); }
                } else {
                    *(u32x4*)(KN + (size_t)row * D + u.pn * 128 + cl0) = pack8s(acc[ai][0][m][0], acc[ai][0][m][1], rs);
                    *(u32x4*)(V + (size_t)row * D + u.pn * 128 + cl0) = pack8s(acc[ai][1][m][0], acc[ai][1][m][1], rs);
                } }
    }
};
struct EpiMix {
    static constexpr bool PERM = true;
    bf16_t* MIX; float* SSM;
    __device__ __forceinline__ void operator()(const f32x4 (&acc)[2][2][4][2], const pg8::Unit& u, int wr, int wc, int fr, int fq) const {
        EPI_ROWS_BEGIN();
#pragma unroll
        for (int ai = 0; ai < 2; ++ai)
#pragma unroll
            for (int m = 0; m < 4; ++m) { const int row = row0 + ai * 128 + m * 16; float ss = 0.f;
#pragma unroll
                for (int bj = 0; bj < 2; ++bj) { *(u32x4*)(MIX + (size_t)row * D + u.pn * 256 + bj * 128 + cl0) = pack8s(acc[ai][bj][m][0], acc[ai][bj][m][1], 1.f); ss += sumsq8(acc[ai][bj][m][0], acc[ai][bj][m][1], 1.f); }
                ss += __shfl_xor(ss, 16); ss += __shfl_xor(ss, 32);
                if (fq == 0) SSM[(size_t)row * 32 + u.pn * 4 + wc] = ss; }
    }
};
struct EpiFfnUp {
    static constexpr bool PERM = true;
    bf16_t* U; const float* rsh;
    __device__ __forceinline__ void operator()(const f32x4 (&acc)[2][2][4][2], const pg8::Unit& u, int wr, int wc, int fr, int fq) const {
        EPI_ROWS_BEGIN();
#pragma unroll
        for (int ai = 0; ai < 2; ++ai)
#pragma unroll
            for (int m = 0; m < 4; ++m) { const int row = row0 + ai * 128 + m * 16; const float rs = rsh[row];
#pragma unroll
                for (int bj = 0; bj < 2; ++bj) *(u32x4*)(U + (size_t)row * FF2 + u.pn * 256 + bj * 128 + cl0) = pack8s(acc[ai][bj][m][0], acc[ai][bj][m][1], rs); }
    }
};
struct EpiMobaKvq {
    static constexpr bool PERM = true;
    unsigned char* wsb; float* KMEAN; const float* rsh; int pn_off;
    __device__ __forceinline__ void operator()(const f32x4 (&acc)[2][2][4][2], const pg8::Unit& u, int wr, int wc, int fr, int fq) const {
        EPI_ROWS_BEGIN();
        const int pe = u.pn + pn_off;
        bf16_t* base = (bf16_t*)(wsb + (pe < 16 ? WS_KB + (size_t)(pe >> 3) * (WS_VB - WS_KB) : WS_Q)); const int ct = (pe & 7) * 256;
        f32x4 cs00 = (f32x4){0.f, 0.f, 0.f, 0.f}, cs01 = cs00, cs10 = cs00, cs11 = cs00;
#pragma unroll
        for (int ai = 0; ai < 2; ++ai)
#pragma unroll
            for (int m = 0; m < 4; ++m) { const int row = row0 + ai * 128 + m * 16; const float rs = rsh[row];
#pragma unroll
                for (int bj = 0; bj < 2; ++bj) *(u32x4*)(base + (size_t)row * D + ct + bj * 128 + cl0) = pack8s(acc[ai][bj][m][0], acc[ai][bj][m][1], rs);
                cs00 += acc[ai][0][m][0] * rs; cs01 += acc[ai][0][m][1] * rs; cs10 += acc[ai][1][m][0] * rs; cs11 += acc[ai][1][m][1] * rs; }
        if (pe < 8) {
#define KM_ADD(CS, bj, n) do { _Pragma("unroll") for (int e = 0; e < 4; ++e) { float v = CS[e]; v += __shfl_xor(v, 1); v += __shfl_xor(v, 2); v += __shfl_xor(v, 4); v += __shfl_xor(v, 8); \
                if (fr == 0) (void)__hip_atomic_fetch_add(KMEAN + (size_t)u.pm * D + ct + (bj) * 128 + cl0 + (n) * 4 + e, v, __ATOMIC_RELAXED, __HIP_MEMORY_SCOPE_AGENT); } } while (0)
            KM_ADD(cs00, 0, 0); KM_ADD(cs01, 0, 1); KM_ADD(cs10, 1, 0); KM_ADD(cs11, 1, 1);
#undef KM_ADD
        }
    }
};

namespace att {
constexpr int V_OFF = 0, KN_OFF = 16384, KR_OFF = 32768, BUF_BYTES = 40960;
constexpr int WS_OFF = 2 * BUF_BYTES, BT_OFF = WS_OFF + 8 * 64 * 4, ATT_LDS = BT_OFF + 512;
#define KSWZ(row, colB) ((row) * 256 + ((colB) ^ (((row) & 7) << 4)))
#define RSWZ(row, colB) ((row) * 128 + ((colB) ^ (((row) & 7) << 4)))
__device__ __forceinline__ int v_st(int k, int c) { const int kk = (k & ~0xC) | ((k & 4) << 1) | ((k & 8) >> 1); return ((kk >> 3) * 4 + (c >> 5)) * 512 + ((kk & 7) * 32 + (c & 31)) * 2; }
__device__ __forceinline__ int v_rd_base(int lane) { return ((lane & 3) << 3) | (((lane >> 2) & 3) << 6) | (((lane >> 4) & 1) << 5) | (((lane >> 5) & 1) << 8); }
constexpr int v_rd_off(int d0, int ks, int half) { return d0 * 512 + ks * 4096 + half * 2048; }
__device__ __forceinline__ int crow(int r, int hi) { return (r & 3) + 8 * (r >> 2) + 4 * hi; }

struct Args { const bf16_t* Q; const bf16_t* K; const bf16_t* KR; const bf16_t* V; bf16_t* O; const unsigned* SEL; const float* relb; const int* pos; };

template <int BUF>
__device__ __forceinline__ void pv_tile(f32x16* o, int vb0, bf16x8 pa0, bf16x8 pa1, bf16x8 pa2, bf16x8 pa3) {
#define TRRD(dst, off) asm volatile("ds_read_b64_tr_b16 %0, %1 offset:%2" : "=&v"(dst) : "v"(vb0), "i"(off) : "memory")
#define PV_D0(d0) do { s16x4 l0, l1, l2, l3, h0, h1, h2, h3; constexpr int b_ = BUF * BUF_BYTES + V_OFF + v_rd_off(d0, 0, 0); \
        TRRD(l0, b_); TRRD(h0, b_ + 2048); TRRD(l1, b_ + 4096); TRRD(h1, b_ + 6144); TRRD(l2, b_ + 8192); TRRD(h2, b_ + 10240); TRRD(l3, b_ + 12288); TRRD(h3, b_ + 14336); \
        asm volatile("s_waitcnt lgkmcnt(0)" ::: "memory"); SBAR(); \
        o[d0] = __builtin_amdgcn_mfma_f32_32x32x16_bf16(pa0, (bf16x8){l0[0], l0[1], l0[2], l0[3], h0[0], h0[1], h0[2], h0[3]}, o[d0], 0, 0, 0); \
        o[d0] = __builtin_amdgcn_mfma_f32_32x32x16_bf16(pa1, (bf16x8){l1[0], l1[1], l1[2], l1[3], h1[0], h1[1], h1[2], h1[3]}, o[d0], 0, 0, 0); \
        o[d0] = __builtin_amdgcn_mfma_f32_32x32x16_bf16(pa2, (bf16x8){l2[0], l2[1], l2[2], l2[3], h2[0], h2[1], h2[2], h2[3]}, o[d0], 0, 0, 0); \
        o[d0] = __builtin_amdgcn_mfma_f32_32x32x16_bf16(pa3, (bf16x8){l3[0], l3[1], l3[2], l3[3], h3[0], h3[1], h3[2], h3[3]}, o[d0], 0, 0, 0); } while (0)
    PV_D0(0); PV_D0(1); PV_D0(2); PV_D0(3);
#undef PV_D0
#undef TRRD
}

template <bool MOBA>
__device__ __forceinline__ void attn_unit(LAS unsigned char* lds, const Args& T, int h, int qb) {
    constexpr int NDQ = MOBA ? 8 : 12, QPITCH = MOBA ? 2048 : 3072, HD = MOBA ? 128 : 192;
    constexpr float SCALE = MOBA ? 0.08838834764831845f : 0.07216878364870323f;
    constexpr float C2 = 1.4426950408889634f * SCALE, THR = 8.f;
    const int tid = opaque_tid(), wid = __builtin_amdgcn_readfirstlane(tid >> 6), lane = tid & 63, r32 = lane & 31, hi = lane >> 5;
    const int q0 = qb * 256, qlo = q0 + wid * 32, qrow = qlo + r32, NT = 4 * (qb + 1), own = qb;
    LAS float* wsf = (LAS float*)(lds + WS_OFF) + wid * 64; LAS float* li_l = wsf; LAS float* al_l = wsf + 32;
    LAS float* btab = (LAS float*)(lds + BT_OFF);
    bf16x8 qr[NDQ];
    { const bf16_t* Qp = T.Q + (size_t)qrow * QPITCH + h * HD + hi * 8;
#pragma unroll
      for (int d0 = 0; d0 < NDQ; ++d0) qr[d0] = *(const bf16x8*)(Qp + d0 * 16); }
    unsigned selm = 0u; int pq = 0;
    if (MOBA) { selm = T.SEL[(size_t)qrow * NH + h]; pq = T.pos[qrow];
        if (tid < 128) { int n = tid, b = n;
            if (n >= 16) { b = 16 + (int)(logf((float)n * (1.0f / 16.0f)) / 2.0794415416798357f * 16.0f); b = b > 31 ? 31 : b; }
            btab[tid] = (T.relb[b * NH + h] - T.relb[31 * NH + h]) * (1.0f / SCALE); } }
    unsigned vk[2], vv[2], vr = 0u;
#pragma unroll
    for (int i = 0; i < 2; ++i) { const int pb = (wid + 8 * i) * 1024 + lane * 16;
        { const int row = pb >> 8, ch = ((pb & 255) >> 4) ^ (row & 7); vk[i] = (unsigned)(row * (D * 2) + ch * 16); }
        { const int sub = pb >> 9, w = (pb & 511) >> 1, kk = (sub >> 2) * 8 + (w >> 5), c = (sub & 3) * 32 + (w & 31);
          const int k = (kk & ~0xC) | ((kk & 4) << 1) | ((kk & 8) >> 1); vv[i] = (unsigned)(k * (D * 2) + c * 2); } }
    if (!MOBA) { const int pb = wid * 1024 + lane * 16, row = pb >> 7, ch = ((pb & 127) >> 4) ^ (row & 7); vr = (unsigned)(row * 128 + ch * 16); }
    const char* Kg = (const char*)(T.K + h * 128); const char* Vg = (const char*)(T.V + h * 128); const char* Rg = (const char*)T.KR;
#define GLDS(g, l) __builtin_amdgcn_global_load_lds((const unsigned*)(g), (LAS unsigned*)(l), 16, 0, 0)
#define DMA_TILE(kb, bf) do { const char* kt_ = Kg + (size_t)(kb) * (D * 2); const char* vt_ = Vg + (size_t)(kb) * (D * 2); \
        GLDS(kt_ + vk[0], lds + (bf) * BUF_BYTES + KN_OFF + wid * 1024); GLDS(kt_ + vk[1], lds + (bf) * BUF_BYTES + KN_OFF + (wid + 8) * 1024); \
        GLDS(vt_ + vv[0], lds + (bf) * BUF_BYTES + V_OFF + wid * 1024); GLDS(vt_ + vv[1], lds + (bf) * BUF_BYTES + V_OFF + (wid + 8) * 1024); \
        if (!MOBA) GLDS(Rg + (size_t)(kb) * 128 + vr, lds + (bf) * BUF_BYTES + KR_OFF + wid * 1024); } while (0)
    const int vb0 = (int)(unsigned)(uintptr_t)(lds) + v_rd_base(lane);
    int kna[4], kra[4];
#pragma unroll
    for (int dd = 0; dd < 4; ++dd) { kna[dd] = KN_OFF + KSWZ(r32, (dd * 16 + hi * 8) * 2); kra[dd] = KR_OFF + RSWZ(r32, (dd * 16 + hi * 8) * 2); }
    float m_reg = -1e30f, l_reg = 0.f; f32x16 o[4];
#pragma unroll
    for (int d = 0; d < 4; ++d) o[d] = f32x16{};
    DMA_TILE(0, 0); VM_WAIT(); __syncthreads();

#define ATT_STEP(t, BUF) do { const int kb = (t) * 64; \
        if ((t) + 1 < NT) DMA_TILE(kb + 64, (BUF) ^ 1); \
        bool keep = true; const int blk = (t) >> 2; \
        if (MOBA && blk < own) keep = ((selm >> blk) & 1u) != 0u; \
        if (!MOBA || __any(keep)) { \
            f32x16 p0 = f32x16{}, p1 = f32x16{}; \
            _Pragma("unroll") for (int d0 = 0; d0 < 8; ++d0) { const LAS unsigned char* a = lds + (BUF) * BUF_BYTES + kna[d0 & 3] + (d0 >> 2) * 128; \
                const bf16x8 b0 = *(const LAS bf16x8*)a, b1 = *(const LAS bf16x8*)(a + 32 * 256); \
                p0 = __builtin_amdgcn_mfma_f32_32x32x16_bf16(b0, qr[d0], p0, 0, 0, 0); p1 = __builtin_amdgcn_mfma_f32_32x32x16_bf16(b1, qr[d0], p1, 0, 0, 0); } \
            if (!MOBA) { _Pragma("unroll") for (int d0 = 0; d0 < 4; ++d0) { const LAS unsigned char* a = lds + (BUF) * BUF_BYTES + kra[d0]; \
                const bf16x8 b0 = *(const LAS bf16x8*)a, b1 = *(const LAS bf16x8*)(a + 32 * 128); \
                p0 = __builtin_amdgcn_mfma_f32_32x32x16_bf16(b0, qr[(NDQ - 4) + d0], p0, 0, 0, 0); p1 = __builtin_amdgcn_mfma_f32_32x32x16_bf16(b1, qr[(NDQ - 4) + d0], p1, 0, 0, 0); } } \
            const float NEGINF = -__builtin_inff(); \
            if (MOBA) { \
                if (!keep) { _Pragma("unroll") for (int r = 0; r < 16; ++r) { p0[r] = NEGINF; p1[r] = NEGINF; } } \
                if (T.pos[qlo] - T.pos[kb + 63] < 128) {     \
                    _Pragma("unroll") for (int g = 0; g < 4; ++g) { const i32x4 pk0 = *(const i32x4*)(T.pos + kb + 8 * g + 4 * hi), pk1 = *(const i32x4*)(T.pos + kb + 32 + 8 * g + 4 * hi); \
                        _Pragma("unroll") for (int e = 0; e < 4; ++e) { const int d0_ = pq - pk0[e], d1_ = pq - pk1[e]; \
                            if ((unsigned)d0_ < 128u) p0[4 * g + e] += btab[d0_]; if ((unsigned)d1_ < 128u) p1[4 * g + e] += btab[d1_]; } } } \
            } \
            if (kb + 63 > qlo) { _Pragma("unroll") for (int r = 0; r < 16; ++r) { const int c = kb + crow(r, hi); if (c > qrow) p0[r] = NEGINF; if (c + 32 > qrow) p1[r] = NEGINF; } } \
            float pmax = p0[0]; _Pragma("unroll") for (int r = 1; r < 16; ++r) pmax = fmaxf(pmax, p0[r]); _Pragma("unroll") for (int r = 0; r < 16; ++r) pmax = fmaxf(pmax, p1[r]); \
            { auto rr_ = __builtin_amdgcn_permlane32_swap(__float_as_uint(pmax), __float_as_uint(pmax), false, false); pmax = fmaxf(__uint_as_float(rr_[0]), __uint_as_float(rr_[1])); } \
            float mn, alpha; \
            if (__all((pmax - m_reg) * SCALE <= THR)) { mn = m_reg; alpha = 1.f; } \
            else { mn = fmaxf(m_reg, pmax); alpha = __builtin_amdgcn_exp2f((m_reg - mn) * C2); m_reg = mn; } \
            const float mnL = -mn * C2; \
            _Pragma("unroll") for (int r = 0; r < 16; ++r) { p0[r] = __builtin_amdgcn_exp2f(fmaf(p0[r], C2, mnL)); p1[r] = __builtin_amdgcn_exp2f(fmaf(p1[r], C2, mnL)); } \
            float ps = 0.f; _Pragma("unroll") for (int r = 0; r < 16; ++r) ps += p0[r]; _Pragma("unroll") for (int r = 0; r < 16; ++r) ps += p1[r]; \
            { auto rr_ = __builtin_amdgcn_permlane32_swap(__float_as_uint(ps), __float_as_uint(ps), false, false); ps = __uint_as_float(rr_[0]) + __uint_as_float(rr_[1]); } \
            l_reg = l_reg * alpha + ps; \
            bf16x8 pa0, pa1, pa2, pa3; \
            PK4(p0, 0, pa0); PK4(p0, 8, pa1); PK4(p1, 0, pa2); PK4(p1, 8, pa3); \
            if (__any(alpha < 1.f)) { if (hi == 0) al_l[r32] = alpha; LDS_WAIT(); \
                _Pragma("unroll") for (int d_ = 0; d_ < 4; ++d_) _Pragma("unroll") for (int r = 0; r < 16; ++r) o[d_][r] *= al_l[crow(r, hi)]; } \
            SBAR(); pv_tile<BUF>(o, vb0, pa0, pa1, pa2, pa3); \
        } \
        VM_WAIT(); __syncthreads(); } while (0)
#define PK4(P, B_, OUT) do { unsigned a0_ = cvt_pk_bf16(P[B_ + 0], P[B_ + 1]), a1_ = cvt_pk_bf16(P[B_ + 2], P[B_ + 3]); \
        unsigned b0_ = cvt_pk_bf16(P[B_ + 4], P[B_ + 5]), b1_ = cvt_pk_bf16(P[B_ + 6], P[B_ + 7]); \
        auto r0_ = __builtin_amdgcn_permlane32_swap(a0_, b0_, false, false); auto r1_ = __builtin_amdgcn_permlane32_swap(a1_, b1_, false, false); \
        u32x4 w_ = {r0_[0], r1_[0], r0_[1], r1_[1]}; OUT = __builtin_bit_cast(bf16x8, w_); } while (0)

    for (int t = 0; t < NT; t += 2) { ATT_STEP(t, 0); ATT_STEP(t + 1, 1); }
#undef PK4
#undef ATT_STEP
#undef DMA_TILE
#undef GLDS
    if (hi == 0) li_l[r32] = l_reg; LDS_WAIT();
    bf16_t* Ow = T.O + (size_t)qlo * D + h * 128;
#pragma unroll
    for (int r = 0; r < 16; ++r) { const int orow = crow(r, hi); const float rl = __builtin_amdgcn_rcpf(li_l[orow]);
#pragma unroll
        for (int d0 = 0; d0 < 4; ++d0) { const float v = o[d0][r] * rl; const float vn = __shfl_xor(v, 1);
            if ((r32 & 1) == 0) *(unsigned*)(Ow + (size_t)orow * D + d0 * 32 + r32) = cvt_pk_bf16(v, vn); } }
    __syncthreads();
}
}

#define XB_TMO      128
#define XB_XCNT(j)  (256  + 64 * (j))
#define XB_XSUB(j)  (1280 + 64 * (j))
#define XB_XGEN(j)  (2304 + 64 * (j))
#define XB_TOP      3328
#define XB_TOPGEN   3392
#define XCD_BAR_WORDS 3456
#define XB_SPIN_CAP (1u << 18)
__device__ __forceinline__ unsigned xb_ld(unsigned* p)              { return __hip_atomic_load(p, __ATOMIC_RELAXED, __HIP_MEMORY_SCOPE_AGENT); }
__device__ __forceinline__ unsigned xb_add(unsigned* p, unsigned v) { return __hip_atomic_fetch_add(p, v, __ATOMIC_RELAXED, __HIP_MEMORY_SCOPE_AGENT); }
__device__ __forceinline__ unsigned xb_xcc_id() { return (unsigned)__builtin_amdgcn_s_getreg((3 << 11) | 20) & 0xFu; }
#define XB_SPIN(cond, bar) do { unsigned _sp = 0; while (cond) { __builtin_amdgcn_s_sleep(1); \
    if ((++_sp & 255u) == 0u) { if (xb_ld(&(bar)[XB_TMO])) break; if (_sp > XB_SPIN_CAP) { atomicAdd(&(bar)[XB_TMO], 1u); break; } } } } while (0)
struct XcdBarrier { unsigned* bar; unsigned x; volatile LAS unsigned* st; };
__device__ __forceinline__ XcdBarrier xcd_barrier_post(unsigned* bar, volatile LAS unsigned* st) {
    XcdBarrier b; b.bar = bar; b.x = xb_xcc_id(); b.st = st;
    if (threadIdx.x == 0) (void)xb_add(&bar[XB_XCNT(b.x)], 1u);
    return b;
}
__device__ __forceinline__ void xcd_barrier_complete(unsigned* bar, unsigned x, unsigned& nloc, unsigned& nx) {
    const unsigned G = gridDim.x * gridDim.y * gridDim.z;
    unsigned sum, cnt, mine, sp = 0u;
    for (;;) {
        sum = 0u; cnt = 0u; mine = 0u;
#pragma unroll
        for (unsigned j = 0; j < 16; ++j) { const unsigned c = xb_ld(&bar[XB_XCNT(j)]); sum += c; cnt += (c > 0u) ? 1u : 0u; mine = (j == x) ? c : mine; }
        if (sum == G) break;
        __builtin_amdgcn_s_sleep(1);
        if ((++sp & 255u) == 0u) { if (xb_ld(&bar[XB_TMO])) break; if (sp > XB_SPIN_CAP) { atomicAdd(&bar[XB_TMO], 1u); break; } }
    }
    nloc = mine > 0u ? mine : 1u; nx = cnt > 0u ? cnt : 1u;
}
__device__ __forceinline__ void xcd_barrier(const XcdBarrier& b) {
    asm volatile("s_waitcnt vmcnt(0)" ::: "memory");
    __syncthreads();
    if (threadIdx.x == 0) {
        unsigned* bar = b.bar;
        __builtin_amdgcn_s_waitcnt(0);
        unsigned nloc = b.st[0], nx = b.st[1];
        if (nloc == 0u) { xcd_barrier_complete(bar, b.x, nloc, nx); b.st[0] = nloc; b.st[1] = nx; }
        const unsigned old = xb_add(&bar[XB_XSUB(b.x)], 1u);
        const unsigned gen = old / nloc;
        if (old + 1u == (gen + 1u) * nloc) {
            __builtin_amdgcn_fence(__ATOMIC_RELEASE, "agent");
            asm volatile("s_waitcnt vmcnt(0)" ::: "memory");
            const unsigned og = xb_add(&bar[XB_TOP], 1u);
            const unsigned tg = og / nx;
            if (og + 1u == (tg + 1u) * nx) xb_add(&bar[XB_TOPGEN], 1u);
            else XB_SPIN(xb_ld(&bar[XB_TOPGEN]) == tg, bar);
            __builtin_amdgcn_fence(__ATOMIC_ACQUIRE, "agent");
            xb_add(&bar[XB_XGEN(b.x)], 1u);
            asm volatile("s_waitcnt vmcnt(0)" ::: "memory");
        } else {
            XB_SPIN(xb_ld(&bar[XB_XGEN(b.x)]) == gen, bar);
            __builtin_amdgcn_fence(__ATOMIC_ACQUIRE, "agent");
            asm volatile("s_waitcnt vmcnt(0)" ::: "memory");
        }
    }
    __syncthreads();
}

struct Params {
    const float* x; const int* pos; const float* gains; const float* a_w_in; const float* a_q_norm; const float* a_w_q_up; const float* a_kv_norm; const float* a_w_kv_up;
    const float* a_w_o; const float* b_kv_norm; const float* b_w_kv; const float* b_w_q; const float* b_w_o; const float* rel_bias; const float* ffn_w_in; const float* ffn_conv_w;
    const float* ffn_conv_b; const float* ffn_w_out; float* out; unsigned char* ws; int ph_lo, ph_hi;
};

struct WDesc { const float* src; const float* gain; bf16_t* dst; int K, Nsrc, Ndst, map; };
__device__ __forceinline__ int colmap(int map, int n) {
    if (map == 1) { if (n < 1024) return n; if (n >= NIN) return -1; const int j = n - 1024; return 1024 + (j >> 1) + (j & 1) * 32; }
    if (map == 2) { const int hh = n / DQK, w = n % DQK; if (w < 128) return n; const int j = w - 128; return hh * DQK + 128 + (j >> 1) + (j & 1) * 32; }
    return n;
}
__device__ __forceinline__ WDesc wdesc(const Params& p, int i) {
    WDesc w; bf16_t* ws = (bf16_t*)p.ws; w.gain = nullptr; w.map = 0;
    if (i < 2) { w.src = p.a_w_in + (size_t)i * D * NIN; w.gain = p.gains + (size_t)(i * 4 + 0) * D; w.dst = (bf16_t*)(p.ws + WS_WIN) + (size_t)i * NINP * D; w.K = D; w.Nsrc = NIN; w.Ndst = NINP; w.map = 1; }
    else if (i < 4) { const int l = i - 2; w.src = p.a_w_q_up + (size_t)l * QL * NQUP; w.gain = p.a_q_norm + l * QL; w.dst = (bf16_t*)(p.ws + WS_WUPG) + (size_t)l * 7168 * 512; w.K = QL; w.Nsrc = NQUP; w.Ndst = NQUP; w.map = 2; }
    else if (i < 6) { const int l = i - 4; w.src = p.a_w_kv_up + (size_t)l * KVL * NKVUP; w.gain = p.a_kv_norm + l * KVL; w.dst = (bf16_t*)(p.ws + WS_WUPG) + (size_t)l * 7168 * 512 + (size_t)NQUP * 512; w.K = KVL; w.Nsrc = NKVUP; w.Ndst = NKVUP; }
    else if (i < 10) { const int l = i - 6; w.src = (l < 2 ? p.a_w_o + (size_t)l * D * D : p.b_w_o + (size_t)(l - 2) * D * D); w.dst = (bf16_t*)(p.ws + WS_WO) + (size_t)l * D * D; w.K = D; w.Nsrc = D; w.Ndst = D; }
    else if (i == 10) { w.src = p.b_w_kv; w.gain = p.b_kv_norm; w.dst = (bf16_t*)(p.ws + WS_WKVQ); w.K = D; w.Nsrc = 4096; w.Ndst = 4096; }
    else if (i == 11) { w.src = p.b_w_q; w.gain = p.gains + (size_t)(2 * 4 + 0) * D; w.dst = (bf16_t*)(p.ws + WS_WKVQ) + (size_t)4096 * D; w.K = D; w.Nsrc = D; w.Ndst = D; }
    else if (i == 12) { w.src = p.b_w_q + (size_t)D * D; w.gain = p.gains + (size_t)(3 * 4 + 0) * D; w.dst = (bf16_t*)(p.ws + WS_WQ1); w.K = D; w.Nsrc = D; w.Ndst = D; }
    else if (i < 17) { const int l = i - 13; w.src = p.ffn_w_in + (size_t)l * D * FF2; w.gain = p.gains + (size_t)(l * 4 + 2) * D; w.dst = (bf16_t*)(p.ws + WS_WUP) + (size_t)l * FF2 * D; w.K = D; w.Nsrc = FF2; w.Ndst = FF2; }
    else { const int l = i - 17; w.src = p.ffn_w_out + (size_t)l * FF * D; w.dst = (bf16_t*)(p.ws + WS_WDN) + (size_t)l * D * FF; w.K = FF; w.Nsrc = D; w.Ndst = D; }
    (void)ws; return w;
}
constexpr int NWDESC = 21;
__device__ __forceinline__ void transpose_item(const WDesc& w, LAS float* scr, int item, int lane) {
    const int nblk = w.Ndst / 32, kb = item / nblk, nb = item % nblk, k0 = 64 * kb, n0 = 32 * nb;
    const int sn = colmap(w.map, n0 + (lane & 31));
#pragma unroll 8
    for (int i = 0; i < 32; ++i) { const int kk = 2 * i + (lane >> 5); float v = 0.f;
        if (sn >= 0) { v = w.src[(size_t)(k0 + kk) * w.Nsrc + sn]; if (w.gain) v *= w.gain[k0 + kk]; }
        scr[kk * 33 + (lane & 31)] = v; }
    LDS_WAIT(); asm volatile("" ::: "memory");
    const int c = lane & 7;
#pragma unroll
    for (int j = 0; j < 4; ++j) { const int n = (lane >> 3) + 8 * j; const LAS float* s = scr + (8 * c) * 33 + n;
        u32x4 o; o.x = cvt_pk_bf16(s[0 * 33], s[1 * 33]); o.y = cvt_pk_bf16(s[2 * 33], s[3 * 33]); o.z = cvt_pk_bf16(s[4 * 33], s[5 * 33]); o.w = cvt_pk_bf16(s[6 * 33], s[7 * 33]);
        *(u32x4*)(w.dst + (size_t)(n0 + n) * w.K + k0 + 8 * c) = o; }
    LDS_WAIT(); asm volatile("" ::: "memory");
}
__device__ __forceinline__ void prologue_phase(const Params& p, LAS unsigned char* lds, int vcu, int G, int wave, int lane) {
    LAS float* scr = (LAS float*)(lds + wave * 16384);
    const int gw = vcu * NWAVES + wave, NGW = G * NWAVES;
    int start = gw;
    for (int d = 0; d < NWDESC; ++d) { const WDesc w = wdesc(p, d); const int n = (w.K / 64) * (w.Ndst / 32);
        int it = start; for (; it < n; it += NGW) transpose_item(w, scr, it, lane);
        start = it - n; }
    bf16_t* HB = (bf16_t*)(p.ws + WS_HB); float* RSH = (float*)(p.ws + WS_RSH);
    for (int row = gw; row < S; row += NGW) { const float* xr = p.x + (size_t)row * D; float ss = 0.f;
#pragma unroll
        for (int j = 0; j < 4; ++j) { const f32x4 a = *(const f32x4*)(xr + j * 512 + lane * 8), b = *(const f32x4*)(xr + j * 512 + lane * 8 + 4);
            ss += sumsq8(a, b, 1.f); *(u32x4*)(HB + (size_t)row * D + j * 512 + lane * 8) = pack8s(a, b, 1.f); }
        ss = wave_sum(ss); if (lane == 0) RSH[row] = rsqrtf(ss * (1.0f / D) + EPS); }
    { float* RC = (float*)(p.ws + WS_RCOS); float* RS = (float*)(p.ws + WS_RSIN);
      for (int i = gw * 64 + lane; i < S * 32; i += NGW * 64) { const int row = i >> 5, k = i & 31;
          const float inv = exp2f(-(float)k * (13.287712379549449f / 32.0f)); const float ang = (float)p.pos[row] * inv;
          const float kq = rintf(ang * 0.15915494309189535f); float r = fmaf(-kq, 6.28125f, ang); r = fmaf(-kq, 1.9353071795864769e-3f, r);
          const float rev = r * 0.15915494309189535f; RC[i] = __builtin_amdgcn_cosf(rev); RS[i] = __builtin_amdgcn_sinf(rev); } }
    float* KM = (float*)(p.ws + WS_KMEAN);
    for (int i = gw * 64 + lane; i < 32 * D; i += NGW * 64) KM[i] = 0.f;
}

__device__ __forceinline__ void resid_phase(const Params& p, const float* hin, const float* gain, int vcu, int G, int wave, int lane) {
    const int gw = vcu * NWAVES + wave, NGW = G * NWAVES;
    const bf16_t* MIX = (const bf16_t*)(p.ws + WS_MIX); const float* SSM = (const float*)(p.ws + WS_SSM);
    bf16_t* HB = (bf16_t*)(p.ws + WS_HB); float* RSH = (float*)(p.ws + WS_RSH);
    for (int row = gw; row < S; row += NGW) {
        float sv = (lane < 32) ? SSM[(size_t)row * 32 + lane] : 0.f; sv = wave_sum(sv);
        const float rs = rsqrtf(sv * (1.0f / D) + EPS); float ss = 0.f;
#pragma unroll
        for (int j = 0; j < 4; ++j) { const int col = j * 512 + lane * 8;
            const u32x4 mw = *(const u32x4*)(MIX + (size_t)row * D + col);
            const f32x4 h0 = *(const f32x4*)(hin + (size_t)row * D + col), h1 = *(const f32x4*)(hin + (size_t)row * D + col + 4);
            const f32x4 g0 = *(const f32x4*)(gain + col), g1 = *(const f32x4*)(gain + col + 4);
            f32x4 a, b;
            a[0] = h0[0] + bflo(mw.x) * rs * g0[0]; a[1] = h0[1] + bfhi(mw.x) * rs * g0[1]; a[2] = h0[2] + bflo(mw.y) * rs * g0[2]; a[3] = h0[3] + bfhi(mw.y) * rs * g0[3];
            b[0] = h1[0] + bflo(mw.z) * rs * g1[0]; b[1] = h1[1] + bfhi(mw.z) * rs * g1[1]; b[2] = h1[2] + bflo(mw.w) * rs * g1[2]; b[3] = h1[3] + bfhi(mw.w) * rs * g1[3];
            *(f32x4*)(p.out + (size_t)row * D + col) = a; *(f32x4*)(p.out + (size_t)row * D + col + 4) = b;
            *(u32x4*)(HB + (size_t)row * D + col) = pack8s(a, b, 1.f); ss += sumsq8(a, b, 1.f); }
        ss = wave_sum(ss); if (lane == 0) RSH[row] = rsqrtf(ss * (1.0f / D) + EPS); }
}
__device__ __forceinline__ float gelu_tanh(float x) {
    const float y = 0.7978845608028654f * (x + 0.044715f * x * x * x);
    const float e = __builtin_amdgcn_exp2f(y * 2.8853900817779268f);
    const float t = 1.0f - 2.0f * __builtin_amdgcn_rcpf(1.0f + e);
    return 0.5f * x * (1.0f + t);
}
__device__ __forceinline__ void convglu_phase(const Params& p, int layer, int vcu, int G, int tid) {
    const bf16_t* U = (const bf16_t*)(p.ws + WS_U); bf16_t* ACT = (bf16_t*)(p.ws + WS_ACT);
    const float* cw = p.ffn_conv_w + (size_t)layer * 3 * FF2; const float* cb = p.ffn_conv_b + (size_t)layer * FF2;
    constexpr int NCH = FF / 8, NTASK = (S / 16) * NCH;
    for (int task = vcu * 512 + tid; task < NTASK; task += G * 512) {
        const int ch = task % NCH, strip = task / NCH, c = ch * 8, s0 = strip * 16;
        float wg[3][8], wu[3][8], bg[8], bu[8];
#pragma unroll
        for (int j = 0; j < 3; ++j) { const f32x4 a = *(const f32x4*)(cw + (size_t)j * FF2 + c), b = *(const f32x4*)(cw + (size_t)j * FF2 + c + 4), cc = *(const f32x4*)(cw + (size_t)j * FF2 + FF + c), d = *(const f32x4*)(cw + (size_t)j * FF2 + FF + c + 4);
#pragma unroll
            for (int e = 0; e < 4; ++e) { wg[j][e] = a[e]; wg[j][4 + e] = b[e]; wu[j][e] = cc[e]; wu[j][4 + e] = d[e]; } }
        { const f32x4 a = *(const f32x4*)(cb + c), b = *(const f32x4*)(cb + c + 4), cc = *(const f32x4*)(cb + FF + c), d = *(const f32x4*)(cb + FF + c + 4);
#pragma unroll
          for (int e = 0; e < 4; ++e) { bg[e] = a[e]; bg[4 + e] = b[e]; bu[e] = cc[e]; bu[4 + e] = d[e]; } }
        float g2[8], g1[8], u2[8], u1[8];
#define LD8(dst, ptr) do { const u32x4 w_ = *(const u32x4*)(ptr); dst[0] = bflo(w_.x); dst[1] = bfhi(w_.x); dst[2] = bflo(w_.y); dst[3] = bfhi(w_.y); dst[4] = bflo(w_.z); dst[5] = bfhi(w_.z); dst[6] = bflo(w_.w); dst[7] = bfhi(w_.w); } while (0)
        if (s0 >= 2) { LD8(g2, U + (size_t)(s0 - 2) * FF2 + c); LD8(g1, U + (size_t)(s0 - 1) * FF2 + c); LD8(u2, U + (size_t)(s0 - 2) * FF2 + FF + c); LD8(u1, U + (size_t)(s0 - 1) * FF2 + FF + c); }
        else {
#pragma unroll
            for (int e = 0; e < 8; ++e) { g2[e] = 0.f; g1[e] = 0.f; u2[e] = 0.f; u1[e] = 0.f; } }
#pragma unroll 4
        for (int r = 0; r < 16; ++r) { float g0[8], u0[8]; LD8(g0, U + (size_t)(s0 + r) * FF2 + c); LD8(u0, U + (size_t)(s0 + r) * FF2 + FF + c);
            float o[8];
#pragma unroll
            for (int e = 0; e < 8; ++e) { const float gt = wg[0][e] * g2[e] + wg[1][e] * g1[e] + wg[2][e] * g0[e] + bg[e]; const float up = wu[0][e] * u2[e] + wu[1][e] * u1[e] + wu[2][e] * u0[e] + bu[e];
                o[e] = gelu_tanh(gt) * up; g2[e] = g1[e]; g1[e] = g0[e]; u2[e] = u1[e]; u1[e] = u0[e]; }
            u32x4 w; w.x = cvt_pk_bf16(o[0], o[1]); w.y = cvt_pk_bf16(o[2], o[3]); w.z = cvt_pk_bf16(o[4], o[5]); w.w = cvt_pk_bf16(o[6], o[7]);
            *(u32x4*)(ACT + (size_t)(s0 + r) * FF + c) = w; }
#undef LD8
    }
}
__device__ __forceinline__ void gate_phase(const Params& p, LAS unsigned char* lds, int vcu, int G, int tid) {
    const bf16_t* Q = (const bf16_t*)(p.ws + WS_Q); const float* KM = (const float*)(p.ws + WS_KMEAN); unsigned* SEL = (unsigned*)(p.ws + WS_SEL);
    LAS float* km = (LAS float*)lds;
    for (int unit = vcu; unit < NH * 16; unit += G) {
        const int h = unit >> 4, qc = unit & 15;
        __syncthreads();
        for (int i = tid; i < 32 * 128; i += 512) km[i] = KM[(size_t)(i >> 7) * D + h * 128 + (i & 127)] * (1.0f / 256.0f);
        __syncthreads();
        const int q = qc * 512 + tid, own = q >> 8;
        float acc[32];
#pragma unroll
        for (int g = 0; g < 4; ++g) { float a8[8];
#pragma unroll
            for (int j = 0; j < 8; ++j) a8[j] = 0.f;
#pragma unroll 1
            for (int d = 0; d < 128; d += 8) { const u32x4 qw = *(const u32x4*)(Q + (size_t)q * D + h * 128 + d);
                const float q0 = bflo(qw.x), q1 = bfhi(qw.x), q2 = bflo(qw.y), q3 = bfhi(qw.y), q4 = bflo(qw.z), q5 = bfhi(qw.z), q6 = bflo(qw.w), q7 = bfhi(qw.w);
#pragma unroll
                for (int j = 0; j < 8; ++j) { const f32x4 k0 = *(const LAS f32x4*)(km + (g * 8 + j) * 128 + d), k1 = *(const LAS f32x4*)(km + (g * 8 + j) * 128 + d + 4);
                    a8[j] += (q0 * k0[0] + q1 * k0[1]) + (q2 * k0[2] + q3 * k0[3]) + (q4 * k1[0] + q5 * k1[1]) + (q6 * k1[2] + q7 * k1[3]); } }
#pragma unroll
            for (int j = 0; j < 8; ++j) acc[g * 8 + j] = a8[j]; }
        unsigned mask = 0u; const int cnt = own < 3 ? own : 3;
#pragma unroll
        for (int k = 0; k < 3; ++k) { if (k < cnt) { float best = -__builtin_inff(); int bi = 0;
#pragma unroll
                for (int n = 0; n < 32; ++n) { const bool ok = (n < own) && !((mask >> n) & 1u) && (acc[n] > best); if (ok) { best = acc[n]; bi = n; } }
                mask |= 1u << bi; } }
        SEL[(size_t)q * NH + h] = mask | (1u << own);
    }
}

__global__ void __launch_bounds__(NWAVES * 64, 2) fwd_kernel(Params p) {
    extern __shared__ __attribute__((aligned(16))) unsigned char lds_raw[];
    LAS unsigned char* lds = (LAS unsigned char*)lds_raw;
    const int tid = threadIdx.x, lane = tid & 63, wave = __builtin_amdgcn_readfirstlane(tid >> 6);
    const int G = gridDim.x; const int bx = blockIdx.x; const int vcu = (G % 8 == 0) ? (bx % 8) * (G / 8) + bx / 8 : bx;
    volatile LAS unsigned* MISC = (volatile LAS unsigned*)(lds + MISC_OFF);
    for (int u = tid; u < (LDS_BYTES - LDSCTL_OFF) / 4; u += NWAVES * 64) ((LAS unsigned*)(lds + LDSCTL_OFF))[u] = 0u;
    __syncthreads();
    unsigned* ctl = (unsigned*)(p.ws + WS_CTL);
    XcdBarrier bar; bar.bar = ctl + CW_BAR; bar.x = 0; bar.st = nullptr;
    const bool one_launch = (p.ph_hi - p.ph_lo) > 1;
    if (one_launch) bar = xcd_barrier_post(ctl + CW_BAR, MISC + 8);
    const int lo = p.ph_lo, hi = p.ph_hi;
    int ph = 0;
#define IN() (lo <= ph && ph < hi)
#define SEAM() do { if (ph + 1 < hi) xcd_barrier(bar); } while (0)

    bf16_t* HB = (bf16_t*)(p.ws + WS_HB); float* RSH = (float*)(p.ws + WS_RSH);
    bf16_t* CQ = (bf16_t*)(p.ws + WS_CQ); bf16_t* CKV = (bf16_t*)(p.ws + WS_CKV); bf16_t* KROPE = (bf16_t*)(p.ws + WS_KROPE); float* SSQ = (float*)(p.ws + WS_SSQ);
    bf16_t* Qb = (bf16_t*)(p.ws + WS_Q); bf16_t* KN = (bf16_t*)(p.ws + WS_KN); bf16_t* Vb = (bf16_t*)(p.ws + WS_V);
    bf16_t* KB = (bf16_t*)(p.ws + WS_KB); bf16_t* VB = (bf16_t*)(p.ws + WS_VB); float* KMEAN = (float*)(p.ws + WS_KMEAN);
    bf16_t* Ob = (bf16_t*)(p.ws + WS_O); bf16_t* MIX = (bf16_t*)(p.ws + WS_MIX); float* SSM = (float*)(p.ws + WS_SSM);
    bf16_t* Ub = (bf16_t*)(p.ws + WS_U); bf16_t* ACT = (bf16_t*)(p.ws + WS_ACT);
    const float* RCOS = (const float*)(p.ws + WS_RCOS); const float* RSIN = (const float*)(p.ws + WS_RSIN);

    if (SITE(0) && IN()) { { const int t_ = opaque_tid(); prologue_phase(p, lds, vcu, G, __builtin_amdgcn_readfirstlane(t_ >> 6), t_ & 63); } SEAM(); } ++ph;

    for (int layer = 0; layer < NLAYER; ++layer) {
        if (layer < 2) {
            if (SITE(1) && IN()) { pg8::Sched Sc; Sc.init(S, D, HB, (const bf16_t*)(p.ws + WS_WIN) + (size_t)layer * NINP * D, NINP, nullptr, nullptr, 0, G, bx);
                EpiMlaIn E{CQ, CKV, KROPE, SSQ, RSH, RCOS, RSIN};
                pg8::gemm_phase<EpiMlaIn, true, true>(lds, D, Sc, E); SEAM(); } ++ph;
            if (SITE(2) && IN()) { const bf16_t* W = (const bf16_t*)(p.ws + WS_WUPG) + (size_t)layer * 7168 * 512;
                pg8::Sched Sc; Sc.init(S, 512, CQ, W, NQUP, CKV, W + (size_t)NQUP * 512, NKVUP, G, bx);
                EpiMlaUp E{Qb, KN, Vb, SSQ, RCOS, RSIN};
                pg8::gemm_phase<EpiMlaUp, true, true>(lds, 512, Sc, E); SEAM(); } ++ph;
            if (SITE(3) && IN()) { att::Args T{Qb, KN, KROPE, Vb, Ob, nullptr, nullptr, p.pos};
                for (int it = vcu; it < NH * 16; it += G) { const int h = it >> 4, y = it & 15;
                    att::attn_unit<false>(lds, T, h, y); att::attn_unit<false>(lds, T, h, 31 - y); }
                SEAM(); } ++ph;
        } else {
            if (SITE(4) && IN()) { const bool first = (layer == 2);
                pg8::Sched Sc; Sc.init(S, D, HB, first ? (const bf16_t*)(p.ws + WS_WKVQ) : (const bf16_t*)(p.ws + WS_WQ1), first ? 6144 : 2048, nullptr, nullptr, 0, G, bx);
                EpiMobaKvq E{p.ws, KMEAN, RSH, first ? 0 : 16};
                pg8::gemm_phase<EpiMobaKvq, true, true>(lds, D, Sc, E); SEAM(); } ++ph;
            if (SITE(5) && IN()) { gate_phase(p, lds, vcu, G, opaque_tid()); SEAM(); } ++ph;
            if (SITE(6) && IN()) { att::Args T{Qb, KB, nullptr, VB, Ob, (const unsigned*)(p.ws + WS_SEL), p.rel_bias, p.pos};
                for (int it = vcu; it < NH * 16; it += G) { const int h = it >> 4, y = it & 15;
                    att::attn_unit<true>(lds, T, h, y); att::attn_unit<true>(lds, T, h, 31 - y); }
                SEAM(); } ++ph;
        }
        if (SITE(7) && IN()) { pg8::Sched Sc; Sc.init(S, D, Ob, (const bf16_t*)(p.ws + WS_WO) + (size_t)layer * D * D, D, nullptr, nullptr, 0, G, bx);
            EpiMix E{MIX, SSM};
            pg8::gemm_phase<EpiMix, false, true>(lds, D, Sc, E); SEAM(); } ++ph;
        if (SITE(8) && IN()) { { const int t_ = opaque_tid(); resid_phase(p, layer == 0 ? p.x : p.out, p.gains + (size_t)(layer * 4 + 1) * D, vcu, G, __builtin_amdgcn_readfirstlane(t_ >> 6), t_ & 63); } SEAM(); } ++ph;
        if (SITE(9) && IN()) { pg8::Sched Sc; Sc.init(S, D, HB, (const bf16_t*)(p.ws + WS_WUP) + (size_t)layer * FF2 * D, FF2, nullptr, nullptr, 0, G, bx);
            EpiFfnUp E{Ub, RSH};
            pg8::gemm_phase<EpiFfnUp, true, true>(lds, D, Sc, E); SEAM(); } ++ph;
        if (SITE(10) && IN()) { convglu_phase(p, layer, vcu, G, opaque_tid()); SEAM(); } ++ph;
        if (SITE(11) && IN()) { pg8::Sched Sc; Sc.init(S, FF, ACT, (const bf16_t*)(p.ws + WS_WDN) + (size_t)layer * D * FF, D, nullptr, nullptr, 0, G, bx);
            EpiMix E{MIX, SSM};
            pg8::gemm_phase<EpiMix, false, true>(lds, FF, Sc, E); SEAM(); } ++ph;
        if (SITE(12) && IN()) { { const int t_ = opaque_tid(); resid_phase(p, p.out, p.gains + (size_t)(layer * 4 + 3) * D, vcu, G, __builtin_amdgcn_readfirstlane(t_ >> 6), t_ & 63); } SEAM(); } ++ph;
    }
#undef IN
#undef SEAM
}

extern "C" void kernel_launch(void* const* d_in, const int* in_sizes, int n_in, void* d_out, int out_size, void* d_ws, size_t ws_size, hipStream_t stream) {
    static int grid = 0;
    if (grid == 0) {
        if (n_in != 18 || in_sizes[0] != S * D || out_size != S * D || ws_size < WS_END) { fprintf(stderr, "kernel_launch: unexpected shapes (n_in %d, in0 %d, out %d, ws %zu)\n", n_in, n_in > 0 ? in_sizes[0] : -1, out_size, ws_size); grid = -1; return; }
        int dev = 0, cus = 0, per_cu = 0;
        if (hipGetDevice(&dev) != hipSuccess || hipDeviceGetAttribute(&cus, hipDeviceAttributeMultiprocessorCount, dev) != hipSuccess) { grid = -1; return; }
        if (hipFuncSetAttribute((const void*)fwd_kernel, hipFuncAttributeMaxDynamicSharedMemorySize, LDS_BYTES) != hipSuccess) { fprintf(stderr, "kernel_launch: hipFuncSetAttribute failed\n"); grid = -1; return; }
        if (hipOccupancyMaxActiveBlocksPerMultiprocessor(&per_cu, (const void*)fwd_kernel, NWAVES * 64, LDS_BYTES) != hipSuccess || per_cu < 1) fprintf(stderr, "kernel_launch: occupancy query reports %d\n", per_cu);
        (void)hipGetLastError();
        grid = cus;
    }
    if (grid < 0) return;
    (void)hipMemsetAsync((char*)d_ws + WS_CTL, 0, CTL_ZERO_BYTES, stream);
    Params p{};
    p.x = (const float*)d_in[0]; p.pos = (const int*)d_in[1]; p.gains = (const float*)d_in[2]; p.a_w_in = (const float*)d_in[3]; p.a_q_norm = (const float*)d_in[4];
    p.a_w_q_up = (const float*)d_in[5]; p.a_kv_norm = (const float*)d_in[6]; p.a_w_kv_up = (const float*)d_in[7]; p.a_w_o = (const float*)d_in[8]; p.b_kv_norm = (const float*)d_in[9];
    p.b_w_kv = (const float*)d_in[10]; p.b_w_q = (const float*)d_in[11]; p.b_w_o = (const float*)d_in[12]; p.rel_bias = (const float*)d_in[13]; p.ffn_w_in = (const float*)d_in[14];
    p.ffn_conv_w = (const float*)d_in[15]; p.ffn_conv_b = (const float*)d_in[16]; p.ffn_w_out = (const float*)d_in[17]; p.out = (float*)d_out; p.ws = (unsigned char*)d_ws;
#if MK_ONE_LAUNCH
    p.ph_lo = 0; p.ph_hi = NPHASE;
    hipLaunchKernelGGL(fwd_kernel, dim3(grid), dim3(NWAVES * 64), LDS_BYTES, stream, p);
#else
    for (int ph = 0; ph < NPHASE; ++ph) { p.ph_lo = ph; p.ph_hi = ph + 1;
        hipLaunchKernelGGL(fwd_kernel, dim3(grid), dim3(NWAVES * 64), LDS_BYTES, stream, p); }
#endif
}
```

```cpp
#include <hip/hip_runtime.h>
#include <cstdio>
#include <cstdint>

#ifndef MK_ONE_LAUNCH
#define MK_ONE_LAUNCH 1
#endif

#ifndef SITE_MASK
#define SITE_MASK 0xFFFF
#endif
#define SITE(n) (((SITE_MASK) >> (n)) & 1)
#ifndef REP_SITE
#define REP_SITE -1
#endif
#ifndef REP_N
#define REP_N 1
#endif
#define REPS(n) for (int rep_ = 0; rep_ < ((n) == (REP_SITE) ? (REP_N) : 1); ++rep_)
#define LAS __attribute__((address_space(3)))
#define GAS __attribute__((address_space(1)))
typedef unsigned short bf16_t;
typedef short bf16x8 __attribute__((ext_vector_type(8)));
typedef short s16x4 __attribute__((ext_vector_type(4)));
typedef float f32x2 __attribute__((ext_vector_type(2)));
typedef float f32x4 __attribute__((ext_vector_type(4)));
typedef float f32x16 __attribute__((ext_vector_type(16)));
typedef unsigned u32x2 __attribute__((ext_vector_type(2)));
typedef unsigned u32x4 __attribute__((ext_vector_type(4)));
typedef int i32x4 __attribute__((ext_vector_type(4)));
typedef GAS unsigned gu32;

constexpr int S = 8192, D = 2048, NH = 16, FF = 5632, FF2 = 11264;
constexpr int QL = 512, KVL = 512, DQK = 192;
constexpr int NIN = 1088, NINP = 1280;
constexpr int NQUP = NH * DQK, NKVUP = NH * 256;
constexpr int NLAYER = 4;
constexpr float EPS = 1e-6f;
constexpr int NPHASE = 1 + NLAYER * 9;

constexpr size_t MiB = 1u << 20;
constexpr size_t WS_CTL = 0, CTL_ZERO_BYTES = 1 * MiB;
constexpr size_t WS_WIN = 2 * MiB;
constexpr size_t WS_WUPG = 12 * MiB;
constexpr size_t WS_WO = 26 * MiB;
constexpr size_t WS_WKVQ = 58 * MiB;
constexpr size_t WS_WQ1 = 82 * MiB;
constexpr size_t WS_WUP = 90 * MiB;
constexpr size_t WS_WDN = 266 * MiB;
constexpr size_t WS_HB = 354 * MiB;
constexpr size_t WS_RSH = 386 * MiB;
constexpr size_t WS_CQ = 387 * MiB;
constexpr size_t WS_CKV = 395 * MiB;
constexpr size_t WS_KROPE = 403 * MiB;
constexpr size_t WS_SSQ = 404 * MiB;
constexpr size_t WS_Q = 405 * MiB;
constexpr size_t WS_KN = 453 * MiB;
constexpr size_t WS_V = 485 * MiB;
constexpr size_t WS_KB = 517 * MiB;
constexpr size_t WS_VB = 549 * MiB;
constexpr size_t WS_KMEAN = 581 * MiB;
constexpr size_t WS_SEL = 582 * MiB;
constexpr size_t WS_O = 583 * MiB;
constexpr size_t WS_MIX = 615 * MiB;
constexpr size_t WS_SSM = 647 * MiB;
constexpr size_t WS_U = 648 * MiB;
constexpr size_t WS_ACT = 824 * MiB;
constexpr size_t WS_RCOS = 912 * MiB;
constexpr size_t WS_RSIN = 913 * MiB;
constexpr size_t WS_END = 914 * MiB;

constexpr int CW_BAR = 4096;

constexpr int RING_BYTES = 131072;
constexpr int LDSCTL_OFF = 139264, MISC_OFF = LDSCTL_OFF + 320;
constexpr int LDS_BYTES = 147456;
constexpr int NWAVES = 8;

#define LDS_WAIT() asm volatile("s_waitcnt lgkmcnt(0)" ::: "memory")
#define VM_WAIT() asm volatile("s_waitcnt vmcnt(0)" ::: "memory")
#define SBAR() __builtin_amdgcn_sched_barrier(0)

__device__ __forceinline__ int opaque_tid() { int t = threadIdx.x; asm volatile("" : "+v"(t)); return t; }
__device__ __forceinline__ unsigned cvt_pk_bf16(float lo, float hi) { unsigned r; asm volatile("v_cvt_pk_bf16_f32 %0, %1, %2" : "=v"(r) : "v"(lo), "v"(hi)); return r; }
__device__ __forceinline__ float bf2f(unsigned short b) { return __uint_as_float(((unsigned)b) << 16); }
__device__ __forceinline__ float bflo(unsigned w) { return __uint_as_float(w << 16); }
__device__ __forceinline__ float bfhi(unsigned w) { return __uint_as_float(w & 0xffff0000u); }
__device__ __forceinline__ float wave_sum(float v) {
#pragma unroll
    for (int o = 1; o < 64; o <<= 1) v += __shfl_xor(v, o);
    return v;
}

namespace pg8 {
constexpr int BM = 256, BK = 64, HALF = 128, HTB = HALF * BK * 2, STAGE_BYTES = 8 * HTB, NXCD = 8, WGM = 8;
__host__ __device__ __forceinline__ int lds_byte(int r, int c) { const int st = (r >> 4) * 2 + (c >> 5), rr = r & 15, cc = c & 31, ob = rr * 64 + cc * 2; return st * 1024 + (ob ^ (((ob >> 9) & 1) << 5)); }
__host__ __device__ __forceinline__ void stage_rc(int b, int& R, int& C) { const int st = b / 1024, sb = b % 1024, swz = sb ^ (((sb >> 9) & 1) << 5); R = (st >> 1) * 16 + swz / 64; C = (st & 1) * 32 + (swz % 64) / 2; }
__host__ __device__ __forceinline__ int perm32(int rho) { const int n = rho >> 4, i = rho & 15; return 8 * (i >> 2) + 4 * n + (i & 3); }

struct Unit { int pm, pn, gi; };

struct Sched {
    int nM, nN0, nwg0, nN1, nwg1, G, c;
    const char* A0; const char* B0; const char* A1; const char* B1; size_t tstep;
    __device__ __forceinline__ void init(int M, int K, const bf16_t* a0, const bf16_t* b0, int N0, const bf16_t* a1, const bf16_t* b1, int N1, int G_, int c_) {
        nM = M / BM; nN0 = N0 / BM; nwg0 = nM * nN0; nN1 = N1 / BM; nwg1 = nM * nN1; G = G_; c = c_;
        A0 = (const char*)a0; B0 = (const char*)b0; A1 = (const char*)a1; B1 = (const char*)b1; tstep = (size_t)BM * K * 2;
    }
    __device__ __forceinline__ void map(int wgid, int nwg, int nN, Unit& u) const {
        { const int q = nwg / NXCD, r = nwg % NXCD, xcd = wgid % NXCD, off = wgid / NXCD; wgid = (xcd < r ? xcd * (q + 1) : r * (q + 1) + (xcd - r) * q) + off; }
        const int nig = WGM * nN, gid = wgid / nig, fm = gid * WGM, gsz = (nM - fm) < WGM ? (nM - fm) : WGM;
        u.pm = fm + ((wgid % nig) % gsz); u.pn = (wgid % nig) / gsz;
    }
    __device__ __forceinline__ bool next(int i, Unit& u) const {
        const long L = (long)i * G + c;
        if (L < nwg0) { u.gi = 0; map((int)L, nwg0, nN0, u); return true; }
        if (L < nwg0 + nwg1) { u.gi = 1; map((int)(L - nwg0), nwg1, nN1, u); return true; }
        return false;
    }
    __device__ __forceinline__ const char* aptr(const Unit& u) const { return (u.gi ? A1 : A0) + (size_t)u.pm * tstep; }
    __device__ __forceinline__ const char* bptr(const Unit& u) const { return (u.gi ? B1 : B0) + (size_t)u.pn * tstep; }
};

template <class Epi, bool ALIGN_EPI, bool SP2>
__device__ __forceinline__ void gemm_phase(LAS unsigned char* lds, const int K, const Sched& S, const Epi& E) {
    const int tid = opaque_tid(), wid = __builtin_amdgcn_readfirstlane(tid >> 6), lane = tid & 63, wr = wid >> 2, wc = wid & 3, fr = lane & 15, fq = lane >> 4;
    const int nt = K / BK;
    unsigned voffA[2], voffB[2];
#pragma unroll
    for (int i = 0; i < 2; ++i) { int R, C; stage_rc(tid * 16 + i * 8192, R, C); const int Rb = Epi::PERM ? ((R & ~31) + perm32(R & 31)) : R;
        voffA[i] = (unsigned)(R * K + C) * 2u; voffB[i] = (unsigned)(Rb * K + C) * 2u; }
    const size_t kstep = (size_t)(BK * 2);
    const size_t hstep = (size_t)HALF * K * 2;
    const unsigned ldsw = (unsigned)wid * 1024u;
    const int aoff = lds_byte(wr * 64 + fr, fq * 8), boff = lds_byte(wc * 32 + fr, fq * 8);
#define PG8_SA(b, h) (((b) * 2 + (h)) * HTB)
#define PG8_SB(b, h) ((4 + (b) * 2 + (h)) * HTB)
#define PG8_STAGE(bufoff, gbase, voff) do { _Pragma("unroll") for (int _i = 0; _i < 2; ++_i) \
        __builtin_amdgcn_global_load_lds((const unsigned*)((const char*)(gbase) + (voff)[_i]), (LAS unsigned*)(lds + (bufoff) + ldsw + _i * 8192), 16, 0, 0); } while (0)
#define PG8_LDA(dst, b, h) do { _Pragma("unroll") for (int m = 0; m < 4; ++m) _Pragma("unroll") for (int k = 0; k < 2; ++k) dst[m][k] = *(const LAS bf16x8*)(lds + PG8_SA(b, h) + aoff + m * 2048 + k * 1024); } while (0)
#define PG8_LDB(dst, b, h) do { _Pragma("unroll") for (int n = 0; n < 2; ++n) _Pragma("unroll") for (int k = 0; k < 2; ++k) dst[n][k] = *(const LAS bf16x8*)(lds + PG8_SB(b, h) + boff + n * 2048 + k * 1024); } while (0)
#define PG8_MMA(ai, bj, At, Bt) do { __builtin_amdgcn_s_setprio(1); _Pragma("unroll") for (int m = 0; m < 4; ++m) _Pragma("unroll") for (int n = 0; n < 2; ++n) _Pragma("unroll") for (int k = 0; k < 2; ++k) \
        acc[ai][bj][m][n] = __builtin_amdgcn_mfma_f32_16x16x32_bf16(Bt[n][k], At[m][k], acc[ai][bj][m][n], 0, 0, 0); __builtin_amdgcn_s_setprio(0); } while (0)
#define PG8_WAIT_V(n) asm volatile("s_waitcnt vmcnt(" #n ")" ::: "memory")
#define PG8_WAIT_L(n) asm volatile("s_waitcnt lgkmcnt(" #n ")" ::: "memory")
#define PG8_BAR __builtin_amdgcn_s_barrier()
#define PG8_SCHED __builtin_amdgcn_sched_barrier(0)
    Unit cur, nxt; int ui = 0;
    if (!S.next(0, cur)) return;
    f32x4 acc[2][2][4][2];
#pragma unroll
    for (int a = 0; a < 2; ++a)
#pragma unroll
        for (int b = 0; b < 2; ++b)
#pragma unroll
            for (int m = 0; m < 4; ++m)
#pragma unroll
                for (int n = 0; n < 2; ++n) acc[a][b][m][n] = (f32x4){0.f, 0.f, 0.f, 0.f};
    bf16x8 At[4][2], B0[2][2], B1[2][2];
    const char* cA = S.aptr(cur); const char* cB = S.bptr(cur);
    if constexpr (SP2) {
        PG8_STAGE(PG8_SB(0, 0), cB, voffB); PG8_STAGE(PG8_SB(0, 1), cB + hstep, voffB); PG8_STAGE(PG8_SA(0, 0), cA, voffA); PG8_STAGE(PG8_SA(0, 1), cA + hstep, voffA);
        if (wr == 1) PG8_BAR;
        PG8_WAIT_V(2); PG8_BAR;
        PG8_STAGE(PG8_SB(1, 0), cB + kstep, voffB); PG8_STAGE(PG8_SA(1, 0), cA + kstep, voffA); PG8_STAGE(PG8_SB(1, 1), cB + hstep + kstep, voffB);
        PG8_WAIT_V(6); PG8_BAR;
    } else {
        PG8_STAGE(PG8_SB(0, 0), cB, voffB); PG8_STAGE(PG8_SA(0, 0), cA, voffA); PG8_STAGE(PG8_SB(0, 1), cB + hstep, voffB); PG8_STAGE(PG8_SA(0, 1), cA + hstep, voffA);
        if (wr == 1) PG8_BAR;
        PG8_WAIT_V(4); PG8_BAR;
        PG8_STAGE(PG8_SB(1, 0), cB + kstep, voffB); PG8_STAGE(PG8_SA(1, 0), cA + kstep, voffA); PG8_STAGE(PG8_SB(1, 1), cB + hstep + kstep, voffB);
        PG8_WAIT_V(6); PG8_BAR;
    }
    for (;;) {
        const bool has_next = S.next(ui + 1, nxt);
        const char* nA = has_next ? S.aptr(nxt) : cA; const char* nB = has_next ? S.bptr(nxt) : cB;
        for (int t = 0; t < nt; t += 2) {
            const bool last = (t == nt - 2);
            const char* a1 = cA + (size_t)(t + 1) * kstep;
            const char* a2 = last ? nA : cA + (size_t)(t + 2) * kstep; const char* b2 = last ? nB : cB + (size_t)(t + 2) * kstep;
            const char* a3 = a2 + kstep; const char* b3 = b2 + kstep;
            if constexpr (SP2) {
            PG8_LDB(B0, 0, 0); PG8_LDB(B1, 0, 1); PG8_SCHED; PG8_LDA(At, 0, 0); PG8_STAGE(PG8_SA(1, 1), a1 + hstep, voffA);
            PG8_WAIT_V(8); PG8_WAIT_L(0); PG8_BAR; PG8_MMA(0, 0, At, B0); PG8_MMA(0, 1, At, B1); PG8_BAR; PG8_SCHED;
            PG8_LDA(At, 0, 1); PG8_STAGE(PG8_SB(0, 0), b2, voffB); PG8_STAGE(PG8_SB(0, 1), b2 + hstep, voffB); PG8_STAGE(PG8_SA(0, 0), a2, voffA);
            PG8_WAIT_V(8); PG8_WAIT_L(0); PG8_BAR; PG8_MMA(1, 0, At, B0); PG8_MMA(1, 1, At, B1); PG8_BAR; PG8_SCHED;
            PG8_LDB(B0, 1, 0); PG8_LDB(B1, 1, 1); PG8_SCHED; PG8_LDA(At, 1, 0); PG8_STAGE(PG8_SA(0, 1), a2 + hstep, voffA);
            PG8_WAIT_V(8); PG8_WAIT_L(0); PG8_BAR; PG8_MMA(0, 0, At, B0); PG8_MMA(0, 1, At, B1); PG8_BAR; PG8_SCHED;
            PG8_LDA(At, 1, 1); PG8_STAGE(PG8_SB(1, 0), b3, voffB); PG8_STAGE(PG8_SB(1, 1), b3 + hstep, voffB); PG8_STAGE(PG8_SA(1, 0), a3, voffA);
            PG8_WAIT_V(8); PG8_WAIT_L(0); PG8_BAR; PG8_MMA(1, 0, At, B0); PG8_MMA(1, 1, At, B1); PG8_BAR; PG8_SCHED;
            } else {
            PG8_LDB(B0, 0, 0); PG8_SCHED; PG8_LDA(At, 0, 0); PG8_STAGE(PG8_SA(1, 1), a1 + hstep, voffA);
            PG8_WAIT_L(8); PG8_BAR; PG8_WAIT_L(0); PG8_MMA(0, 0, At, B0); PG8_BAR; PG8_SCHED;
            PG8_LDB(B1, 0, 1); PG8_STAGE(PG8_SB(0, 0), b2, voffB);
            PG8_BAR; PG8_WAIT_L(0); PG8_MMA(0, 1, At, B1); PG8_BAR;
            PG8_LDA(At, 0, 1); PG8_STAGE(PG8_SA(0, 0), a2, voffA);
            PG8_BAR; PG8_WAIT_L(0); PG8_MMA(1, 0, At, B0); PG8_BAR; PG8_SCHED;
            PG8_STAGE(PG8_SB(0, 1), b2 + hstep, voffB);
            PG8_WAIT_V(6); PG8_BAR; PG8_MMA(1, 1, At, B1); PG8_BAR;
            PG8_LDB(B0, 1, 0); PG8_SCHED; PG8_LDA(At, 1, 0); PG8_STAGE(PG8_SA(0, 1), a2 + hstep, voffA);
            PG8_WAIT_L(8); PG8_BAR; PG8_WAIT_L(0); PG8_MMA(0, 0, At, B0); PG8_BAR; PG8_SCHED;
            PG8_LDB(B1, 1, 1); PG8_STAGE(PG8_SB(1, 0), b3, voffB);
            PG8_BAR; PG8_WAIT_L(0); PG8_MMA(0, 1, At, B1); PG8_BAR;
            PG8_LDA(At, 1, 1); PG8_STAGE(PG8_SA(1, 0), a3, voffA);
            PG8_BAR; PG8_WAIT_L(0); PG8_MMA(1, 0, At, B0); PG8_BAR; PG8_SCHED;
            PG8_STAGE(PG8_SB(1, 1), b3 + hstep, voffB);
            PG8_WAIT_V(6); PG8_BAR; PG8_MMA(1, 1, At, B1); PG8_BAR;
            }
        }
        if constexpr (ALIGN_EPI) { if (wr == 0) PG8_BAR; }
        E(acc, cur, wr, wc, fr, fq);
        if (!has_next) break;
#pragma unroll
        for (int a = 0; a < 2; ++a)
#pragma unroll
            for (int b = 0; b < 2; ++b)
#pragma unroll
                for (int m = 0; m < 4; ++m)
#pragma unroll
                    for (int n = 0; n < 2; ++n) acc[a][b][m][n] = (f32x4){0.f, 0.f, 0.f, 0.f};
        cur = nxt; cA = nA; cB = nB; ++ui;
        if constexpr (ALIGN_EPI) { if (wr == 1) PG8_BAR; }
    }
    PG8_WAIT_V(0);
    if constexpr (!ALIGN_EPI) { if (wr == 0) PG8_BAR; }
    PG8_BAR;
#undef PG8_SA
#undef PG8_SB
#undef PG8_STAGE
#undef PG8_LDA
#undef PG8_LDB
#undef PG8_MMA
#undef PG8_WAIT_V
#undef PG8_WAIT_L
#undef PG8_BAR
#undef PG8_SCHED
}
}

#define EPI_ROWS_BEGIN() const int row0 = u.pm * 256 + wr * 64 + fr; const int cl0 = wc * 32 + 8 * fq;
__device__ __forceinline__ u32x4 pack8s(f32x4 a, f32x4 b, float s) {
    u32x4 w; w.x = cvt_pk_bf16(a[0] * s, a[1] * s); w.y = cvt_pk_bf16(a[2] * s, a[3] * s); w.z = cvt_pk_bf16(b[0] * s, b[1] * s); w.w = cvt_pk_bf16(b[2] * s, b[3] * s); return w;
}
__device__ __forceinline__ float sumsq8(f32x4 a, f32x4 b, float s) {
    a = a * s; b = b * s; return (a[0] * a[0] + a[1] * a[1]) + (a[2] * a[2] + a[3] * a[3]) + (b[0] * b[0] + b[1] * b[1]) + (b[2] * b[2] + b[3] * b[3]);
}
__device__ __forceinline__ void rope8(f32x4& a, f32x4& b, const float* ctab, const float* stab, int row, int i0) {
    const f32x4 cs = *(const f32x4*)(ctab + (size_t)row * 32 + i0), sn = *(const f32x4*)(stab + (size_t)row * 32 + i0);
    const f32x4 a2 = (f32x4){a[0] * cs[0] - a[1] * sn[0], a[0] * sn[0] + a[1] * cs[0], a[2] * cs[1] - a[3] * sn[1], a[2] * sn[1] + a[3] * cs[1]};
    const f32x4 b2 = (f32x4){b[0] * cs[2] - b[1] * sn[2], b[0] * sn[2] + b[1] * cs[2], b[2] * cs[3] - b[3] * sn[3], b[2] * sn[3] + b[3] * cs[3]};
    a = a2; b = b2;
}

struct EpiMlaIn {
    static constexpr bool PERM = true;
    bf16_t* CQ; bf16_t* CKV; bf16_t* KR; float* SSQ; const float* rsh; const float* ctab; const float* stab;
    __device__ __forceinline__ void operator()(const f32x4 (&acc)[2][2][4][2], const pg8::Unit& u, int wr, int wc, int fr, int fq) const {
        EPI_ROWS_BEGIN();
        if (u.pn < 4) {
            bf16_t* base = (u.pn < 2 ? CQ : CKV) + (u.pn & 1) * 256;
#pragma unroll
            for (int ai = 0; ai < 2; ++ai)
#pragma unroll
                for (int m = 0; m < 4; ++m) { const int row = row0 + ai * 128 + m * 16; const float rs = rsh[row]; float ss = 0.f;
#pragma unroll
                    for (int bj = 0; bj < 2; ++bj) { *(u32x4*)(base + (size_t)row * 512 + bj * 128 + cl0) = pack8s(acc[ai][bj][m][0], acc[ai][bj][m][1], rs); ss += sumsq8(acc[ai][bj][m][0], acc[ai][bj][m][1], rs); }
                    ss += __shfl_xor(ss, 16); ss += __shfl_xor(ss, 32);
                    if (fq == 0) SSQ[(size_t)row * 16 + (u.pn >> 1) * 8 + (u.pn & 1) * 4 + wc] = ss; }
        } else if (wc < 2) {
#pragma unroll
            for (int ai = 0; ai < 2; ++ai)
#pragma unroll
                for (int m = 0; m < 4; ++m) { const int row = row0 + ai * 128 + m * 16; const float rs = rsh[row];
                    f32x4 a = acc[ai][0][m][0] * rs, b = acc[ai][0][m][1] * rs; rope8(a, b, ctab, stab, row, cl0 >> 1);
                    *(u32x4*)(KR + (size_t)row * 64 + cl0) = pack8s(a, b, 1.f); }
        }
    }
};
struct EpiMlaUp {
    static constexpr bool PERM = true;
    bf16_t* Q; bf16_t* KN; bf16_t* V; const float* SSQ; const float* ctab; const float* stab;
    __device__ __forceinline__ void operator()(const f32x4 (&acc)[2][2][4][2], const pg8::Unit& u, int wr, int wc, int fr, int fq) const {
        EPI_ROWS_BEGIN();
#pragma unroll
        for (int ai = 0; ai < 2; ++ai)
#pragma unroll
            for (int m = 0; m < 4; ++m) { const int row = row0 + ai * 128 + m * 16;
                const f32x4 s0 = *(const f32x4*)(SSQ + (size_t)row * 16 + u.gi * 8), s1 = *(const f32x4*)(SSQ + (size_t)row * 16 + u.gi * 8 + 4);
                const float ss = ((s0[0] + s0[1]) + (s0[2] + s0[3])) + ((s1[0] + s1[1]) + (s1[2] + s1[3]));
                const float rs = rsqrtf(ss * (1.0f / 512.0f) + EPS);
                if (u.gi == 0) {
#pragma unroll
                    for (int bj = 0; bj < 2; ++bj) { const int col = u.pn * 256 + bj * 128 + cl0; const int w = col % DQK;
                        f32x4 a = acc[ai][bj][m][0] * rs, b = acc[ai][bj][m][1] * rs;
                        if (w >= 128) rope8(a, b, ctab, stab, row, (w - 128) >> 1);
                        *(u32x4*)(Q + (size_t)row * NQUP + col) = pack8s(a, b, 1.f); }
                } else {
                    *(u32x4*)(KN + (size_t)row * D + u.pn * 128 + cl0) = pack8s(acc[ai][0][m][0], acc[ai][0][m][1], rs);
                    *(u32x4*)(V + (size_t)row * D + u.pn * 128 + cl0) = pack8s(acc[ai][1][m][0], acc[ai][1][m][1], rs);
                } }
    }
};
struct EpiMix {
    static constexpr bool PERM = true;
    bf16_t* MIX; float* SSM;
    __device__ __forceinline__ void operator()(const f32x4 (&acc)[2][2][4][2], const pg8::Unit& u, int wr, int wc, int fr, int fq) const {
        EPI_ROWS_BEGIN();
#pragma unroll
        for (int ai = 0; ai < 2; ++ai)
#pragma unroll
            for (int m = 0; m < 4; ++m) { const int row = row0 + ai * 128 + m * 16; float ss = 0.f;
#pragma unroll
                for (int bj = 0; bj < 2; ++bj) { *(u32x4*)(MIX + (size_t)row * D + u.pn * 256 + bj * 128 + cl0) = pack8s(acc[ai][bj][m][0], acc[ai][bj][m][1], 1.f); ss += sumsq8(acc[ai][bj][m][0], acc[ai][bj][m][1], 1.f); }
                ss += __shfl_xor(ss, 16); ss += __shfl_xor(ss, 32);
                if (fq == 0) SSM[(size_t)row * 32 + u.pn * 4 + wc] = ss; }
    }
};
struct EpiFfnUp {
    static constexpr bool PERM = true;
    bf16_t* U; const float* rsh;
    __device__ __forceinline__ void operator()(const f32x4 (&acc)[2][2][4][2], const pg8::Unit& u, int wr, int wc, int fr, int fq) const {
        EPI_ROWS_BEGIN();
#pragma unroll
        for (int ai = 0; ai < 2; ++ai)
#pragma unroll
            for (int m = 0; m < 4; ++m) { const int row = row0 + ai * 128 + m * 16; const float rs = rsh[row];
#pragma unroll
                for (int bj = 0; bj < 2; ++bj) *(u32x4*)(U + (size_t)row * FF2 + u.pn * 256 + bj * 128 + cl0) = pack8s(acc[ai][bj][m][0], acc[ai][bj][m][1], rs); }
    }
};
struct EpiMobaKvq {
    static constexpr bool PERM = true;
    unsigned char* wsb; float* KMEAN; const float* rsh; int pn_off;
    __device__ __forceinline__ void operator()(const f32x4 (&acc)[2][2][4][2], const pg8::Unit& u, int wr, int wc, int fr, int fq) const {
        EPI_ROWS_BEGIN();
        const int pe = u.pn + pn_off;
        bf16_t* base = (bf16_t*)(wsb + (pe < 16 ? WS_KB + (size_t)(pe >> 3) * (WS_VB - WS_KB) : WS_Q)); const int ct = (pe & 7) * 256;
        f32x4 cs00 = (f32x4){0.f, 0.f, 0.f, 0.f}, cs01 = cs00, cs10 = cs00, cs11 = cs00;
#pragma unroll
        for (int ai = 0; ai < 2; ++ai)
#pragma unroll
            for (int m = 0; m < 4; ++m) { const int row = row0 + ai * 128 + m * 16; const float rs = rsh[row];
#pragma unroll
                for (int bj = 0; bj < 2; ++bj) *(u32x4*)(base + (size_t)row * D + ct + bj * 128 + cl0) = pack8s(acc[ai][bj][m][0], acc[ai][bj][m][1], rs);
                cs00 += acc[ai][0][m][0] * rs; cs01 += acc[ai][0][m][1] * rs; cs10 += acc[ai][1][m][0] * rs; cs11 += acc[ai][1][m][1] * rs; }
        if (pe < 8) {
#define KM_ADD(CS, bj, n) do { _Pragma("unroll") for (int e = 0; e < 4; ++e) { float v = CS[e]; v += __shfl_xor(v, 1); v += __shfl_xor(v, 2); v += __shfl_xor(v, 4); v += __shfl_xor(v, 8); \
                if (fr == 0) (void)__hip_atomic_fetch_add(KMEAN + (size_t)u.pm * D + ct + (bj) * 128 + cl0 + (n) * 4 + e, v, __ATOMIC_RELAXED, __HIP_MEMORY_SCOPE_AGENT); } } while (0)
            KM_ADD(cs00, 0, 0); KM_ADD(cs01, 0, 1); KM_ADD(cs10, 1, 0); KM_ADD(cs11, 1, 1);
#undef KM_ADD
        }
    }
};

namespace att {
constexpr int V_OFF = 0, KN_OFF = 16384, KR_OFF = 32768, BUF_BYTES = 40960;
constexpr int WS_OFF = 2 * BUF_BYTES, BT_OFF = WS_OFF + 8 * 64 * 4, ATT_LDS = BT_OFF + 512;
#define KSWZ(row, colB) ((row) * 256 + ((colB) ^ (((row) & 7) << 4)))
#define RSWZ(row, colB) ((row) * 128 + ((colB) ^ (((row) & 7) << 4)))
__device__ __forceinline__ int v_st(int k, int c) { const int kk = (k & ~0xC) | ((k & 4) << 1) | ((k & 8) >> 1); return ((kk >> 3) * 4 + (c >> 5)) * 512 + ((kk & 7) * 32 + (c & 31)) * 2; }
__device__ __forceinline__ int v_rd_base(int lane) { return ((lane & 3) << 3) | (((lane >> 2) & 3) << 6) | (((lane >> 4) & 1) << 5) | (((lane >> 5) & 1) << 8); }
constexpr int v_rd_off(int d0, int ks, int half) { return d0 * 512 + ks * 4096 + half * 2048; }
__device__ __forceinline__ int crow(int r, int hi) { return (r & 3) + 8 * (r >> 2) + 4 * hi; }

struct Args { const bf16_t* Q; const bf16_t* K; const bf16_t* KR; const bf16_t* V; bf16_t* O; const unsigned* SEL; const float* relb; const int* pos; };

template <int BUF>
__device__ __forceinline__ void pv_tile(f32x16* o, int vb0, bf16x8 pa0, bf16x8 pa1, bf16x8 pa2, bf16x8 pa3) {
#define TRRD(dst, off) asm volatile("ds_read_b64_tr_b16 %0, %1 offset:%2" : "=&v"(dst) : "v"(vb0), "i"(off) : "memory")
#define PV_D0(d0) do { s16x4 l0, l1, l2, l3, h0, h1, h2, h3; constexpr int b_ = BUF * BUF_BYTES + V_OFF + v_rd_off(d0, 0, 0); \
        TRRD(l0, b_); TRRD(h0, b_ + 2048); TRRD(l1, b_ + 4096); TRRD(h1, b_ + 6144); TRRD(l2, b_ + 8192); TRRD(h2, b_ + 10240); TRRD(l3, b_ + 12288); TRRD(h3, b_ + 14336); \
        asm volatile("s_waitcnt lgkmcnt(0)" ::: "memory"); SBAR(); \
        o[d0] = __builtin_amdgcn_mfma_f32_32x32x16_bf16(pa0, (bf16x8){l0[0], l0[1], l0[2], l0[3], h0[0], h0[1], h0[2], h0[3]}, o[d0], 0, 0, 0); \
        o[d0] = __builtin_amdgcn_mfma_f32_32x32x16_bf16(pa1, (bf16x8){l1[0], l1[1], l1[2], l1[3], h1[0], h1[1], h1[2], h1[3]}, o[d0], 0, 0, 0); \
        o[d0] = __builtin_amdgcn_mfma_f32_32x32x16_bf16(pa2, (bf16x8){l2[0], l2[1], l2[2], l2[3], h2[0], h2[1], h2[2], h2[3]}, o[d0], 0, 0, 0); \
        o[d0] = __builtin_amdgcn_mfma_f32_32x32x16_bf16(pa3, (bf16x8){l3[0], l3[1], l3[2], l3[3], h3[0], h3[1], h3[2], h3[3]}, o[d0], 0, 0, 0); } while (0)
    PV_D0(0); PV_D0(1); PV_D0(2); PV_D0(3);
#undef PV_D0
#undef TRRD
}

template <bool MOBA>
__device__ __forceinline__ void attn_unit(LAS unsigned char* lds, const Args& T, int h, int qb) {
    constexpr int NDQ = MOBA ? 8 : 12, QPITCH = MOBA ? 2048 : 3072, HD = MOBA ? 128 : 192;
    constexpr float SCALE = MOBA ? 0.08838834764831845f : 0.07216878364870323f;
    constexpr float C2 = 1.4426950408889634f * SCALE, THR = 8.f;
    const int tid = opaque_tid(), wid = __builtin_amdgcn_readfirstlane(tid >> 6), lane = tid & 63, r32 = lane & 31, hi = lane >> 5;
    const int q0 = qb * 256, qlo = q0 + wid * 32, qrow = qlo + r32, NT = 4 * (qb + 1), own = qb;
    LAS float* wsf = (LAS float*)(lds + WS_OFF) + wid * 64; LAS float* li_l = wsf; LAS float* al_l = wsf + 32;
    LAS float* btab = (LAS float*)(lds + BT_OFF);
    bf16x8 qr[NDQ];
    { const bf16_t* Qp = T.Q + (size_t)qrow * QPITCH + h * HD + hi * 8;
#pragma unroll
      for (int d0 = 0; d0 < NDQ; ++d0) qr[d0] = *(const bf16x8*)(Qp + d0 * 16); }
    unsigned selm = 0u; int pq = 0;
    if (MOBA) { selm = T.SEL[(size_t)qrow * NH + h]; pq = T.pos[qrow];
        if (tid < 128) { int n = tid, b = n;
            if (n >= 16) { b = 16 + (int)(logf((float)n * (1.0f / 16.0f)) / 2.0794415416798357f * 16.0f); b = b > 31 ? 31 : b; }
            btab[tid] = (T.relb[b * NH + h] - T.relb[31 * NH + h]) * (1.0f / SCALE); } }
    unsigned vk[2], vv[2], vr = 0u;
#pragma unroll
    for (int i = 0; i < 2; ++i) { const int pb = (wid + 8 * i) * 1024 + lane * 16;
        { const int row = pb >> 8, ch = ((pb & 255) >> 4) ^ (row & 7); vk[i] = (unsigned)(row * (D * 2) + ch * 16); }
        { const int sub = pb >> 9, w = (pb & 511) >> 1, kk = (sub >> 2) * 8 + (w >> 5), c = (sub & 3) * 32 + (w & 31);
          const int k = (kk & ~0xC) | ((kk & 4) << 1) | ((kk & 8) >> 1); vv[i] = (unsigned)(k * (D * 2) + c * 2); } }
    if (!MOBA) { const int pb = wid * 1024 + lane * 16, row = pb >> 7, ch = ((pb & 127) >> 4) ^ (row & 7); vr = (unsigned)(row * 128 + ch * 16); }
    const char* Kg = (const char*)(T.K + h * 128); const char* Vg = (const char*)(T.V + h * 128); const char* Rg = (const char*)T.KR;
#define GLDS(g, l) __builtin_amdgcn_global_load_lds((const unsigned*)(g), (LAS unsigned*)(l), 16, 0, 0)
#define DMA_TILE(kb, bf) do { const char* kt_ = Kg + (size_t)(kb) * (D * 2); const char* vt_ = Vg + (size_t)(kb) * (D * 2); \
        GLDS(kt_ + vk[0], lds + (bf) * BUF_BYTES + KN_OFF + wid * 1024); GLDS(kt_ + vk[1], lds + (bf) * BUF_BYTES + KN_OFF + (wid + 8) * 1024); \
        GLDS(vt_ + vv[0], lds + (bf) * BUF_BYTES + V_OFF + wid * 1024); GLDS(vt_ + vv[1], lds + (bf) * BUF_BYTES + V_OFF + (wid + 8) * 1024); \
        if (!MOBA) GLDS(Rg + (size_t)(kb) * 128 + vr, lds + (bf) * BUF_BYTES + KR_OFF + wid * 1024); } while (0)
    const int vb0 = (int)(unsigned)(uintptr_t)(lds) + v_rd_base(lane);
    int kna[4], kra[4];
#pragma unroll
    for (int dd = 0; dd < 4; ++dd) { kna[dd] = KN_OFF + KSWZ(r32, (dd * 16 + hi * 8) * 2); kra[dd] = KR_OFF + RSWZ(r32, (dd * 16 + hi * 8) * 2); }
    float m_reg = -1e30f, l_reg = 0.f; f32x16 o[4];
#pragma unroll
    for (int d = 0; d < 4; ++d) o[d] = f32x16{};
    DMA_TILE(0, 0); VM_WAIT(); __syncthreads();

#define ATT_STEP(t, BUF) do { const int kb = (t) * 64; \
        if ((t) + 1 < NT) DMA_TILE(kb + 64, (BUF) ^ 1); \
        bool keep = true; const int blk = (t) >> 2; \
        if (MOBA && blk < own) keep = ((selm >> blk) & 1u) != 0u; \
        if (!MOBA || __any(keep)) { \
            f32x16 p0 = f32x16{}, p1 = f32x16{}; \
            _Pragma("unroll") for (int d0 = 0; d0 < 8; ++d0) { const LAS unsigned char* a = lds + (BUF) * BUF_BYTES + kna[d0 & 3] + (d0 >> 2) * 128; \
                const bf16x8 b0 = *(const LAS bf16x8*)a, b1 = *(const LAS bf16x8*)(a + 32 * 256); \
                p0 = __builtin_amdgcn_mfma_f32_32x32x16_bf16(b0, qr[d0], p0, 0, 0, 0); p1 = __builtin_amdgcn_mfma_f32_32x32x16_bf16(b1, qr[d0], p1, 0, 0, 0); } \
            if (!MOBA) { _Pragma("unroll") for (int d0 = 0; d0 < 4; ++d0) { const LAS unsigned char* a = lds + (BUF) * BUF_BYTES + kra[d0]; \
                const bf16x8 b0 = *(const LAS bf16x8*)a, b1 = *(const LAS bf16x8*)(a + 32 * 128); \
                p0 = __builtin_amdgcn_mfma_f32_32x32x16_bf16(b0, qr[(NDQ - 4) + d0], p0, 0, 0, 0); p1 = __builtin_amdgcn_mfma_f32_32x32x16_bf16(b1, qr[(NDQ - 4) + d0], p1, 0, 0, 0); } } \
            const float NEGINF = -__builtin_inff(); \
            if (MOBA) { \
                if (!keep) { _Pragma("unroll") for (int r = 0; r < 16; ++r) { p0[r] = NEGINF; p1[r] = NEGINF; } } \
                if (T.pos[qlo] - T.pos[kb + 63] < 128) {     \
                    _Pragma("unroll") for (int g = 0; g < 4; ++g) { const i32x4 pk0 = *(const i32x4*)(T.pos + kb + 8 * g + 4 * hi), pk1 = *(const i32x4*)(T.pos + kb + 32 + 8 * g + 4 * hi); \
                        _Pragma("unroll") for (int e = 0; e < 4; ++e) { const int d0_ = pq - pk0[e], d1_ = pq - pk1[e]; \
                            if ((unsigned)d0_ < 128u) p0[4 * g + e] += btab[d0_]; if ((unsigned)d1_ < 128u) p1[4 * g + e] += btab[d1_]; } } } \
            } \
            if (kb + 63 > qlo) { _Pragma("unroll") for (int r = 0; r < 16; ++r) { const int c = kb + crow(r, hi); if (c > qrow) p0[r] = NEGINF; if (c + 32 > qrow) p1[r] = NEGINF; } } \
            float pmax = p0[0]; _Pragma("unroll") for (int r = 1; r < 16; ++r) pmax = fmaxf(pmax, p0[r]); _Pragma("unroll") for (int r = 0; r < 16; ++r) pmax = fmaxf(pmax, p1[r]); \
            { auto rr_ = __builtin_amdgcn_permlane32_swap(__float_as_uint(pmax), __float_as_uint(pmax), false, false); pmax = fmaxf(__uint_as_float(rr_[0]), __uint_as_float(rr_[1])); } \
            float mn, alpha; \
            if (__all((pmax - m_reg) * SCALE <= THR)) { mn = m_reg; alpha = 1.f; } \
            else { mn = fmaxf(m_reg, pmax); alpha = __builtin_amdgcn_exp2f((m_reg - mn) * C2); m_reg = mn; } \
            const float mnL = -mn * C2; \
            _Pragma("unroll") for (int r = 0; r < 16; ++r) { p0[r] = __builtin_amdgcn_exp2f(fmaf(p0[r], C2, mnL)); p1[r] = __builtin_amdgcn_exp2f(fmaf(p1[r], C2, mnL)); } \
            float ps = 0.f; _Pragma("unroll") for (int r = 0; r < 16; ++r) ps += p0[r]; _Pragma("unroll") for (int r = 0; r < 16; ++r) ps += p1[r]; \
            { auto rr_ = __builtin_amdgcn_permlane32_swap(__float_as_uint(ps), __float_as_uint(ps), false, false); ps = __uint_as_float(rr_[0]) + __uint_as_float(rr_[1]); } \
            l_reg = l_reg * alpha + ps; \
            bf16x8 pa0, pa1, pa2, pa3; \
            PK4(p0, 0, pa0); PK4(p0, 8, pa1); PK4(p1, 0, pa2); PK4(p1, 8, pa3); \
            if (__any(alpha < 1.f)) { if (hi == 0) al_l[r32] = alpha; LDS_WAIT(); \
                _Pragma("unroll") for (int d_ = 0; d_ < 4; ++d_) _Pragma("unroll") for (int r = 0; r < 16; ++r) o[d_][r] *= al_l[crow(r, hi)]; } \
            SBAR(); pv_tile<BUF>(o, vb0, pa0, pa1, pa2, pa3); \
        } \
        VM_WAIT(); __syncthreads(); } while (0)
#define PK4(P, B_, OUT) do { unsigned a0_ = cvt_pk_bf16(P[B_ + 0], P[B_ + 1]), a1_ = cvt_pk_bf16(P[B_ + 2], P[B_ + 3]); \
        unsigned b0_ = cvt_pk_bf16(P[B_ + 4], P[B_ + 5]), b1_ = cvt_pk_bf16(P[B_ + 6], P[B_ + 7]); \
        auto r0_ = __builtin_amdgcn_permlane32_swap(a0_, b0_, false, false); auto r1_ = __builtin_amdgcn_permlane32_swap(a1_, b1_, false, false); \
        u32x4 w_ = {r0_[0], r1_[0], r0_[1], r1_[1]}; OUT = __builtin_bit_cast(bf16x8, w_); } while (0)

    for (int t = 0; t < NT; t += 2) { ATT_STEP(t, 0); ATT_STEP(t + 1, 1); }
#undef PK4
#undef ATT_STEP
#undef DMA_TILE
#undef GLDS
    if (hi == 0) li_l[r32] = l_reg; LDS_WAIT();
    bf16_t* Ow = T.O + (size_t)qlo * D + h * 128;
#pragma unroll
    for (int r = 0; r < 16; ++r) { const int orow = crow(r, hi); const float rl = __builtin_amdgcn_rcpf(li_l[orow]);
#pragma unroll
        for (int d0 = 0; d0 < 4; ++d0) { const float v = o[d0][r] * rl; const float vn = __shfl_xor(v, 1);
            if ((r32 & 1) == 0) *(unsigned*)(Ow + (size_t)orow * D + d0 * 32 + r32) = cvt_pk_bf16(v, vn); } }
    __syncthreads();
}
}

#define XB_TMO      128
#define XB_XCNT(j)  (256  + 64 * (j))
#define XB_XSUB(j)  (1280 + 64 * (j))
#define XB_XGEN(j)  (2304 + 64 * (j))
#define XB_TOP      3328
#define XB_TOPGEN   3392
#define XCD_BAR_WORDS 3456
#define XB_SPIN_CAP (1u << 18)
__device__ __forceinline__ unsigned xb_ld(unsigned* p)              { return __hip_atomic_load(p, __ATOMIC_RELAXED, __HIP_MEMORY_SCOPE_AGENT); }
__device__ __forceinline__ unsigned xb_add(unsigned* p, unsigned v) { return __hip_atomic_fetch_add(p, v, __ATOMIC_RELAXED, __HIP_MEMORY_SCOPE_AGENT); }
__device__ __forceinline__ unsigned xb_xcc_id() { return (unsigned)__builtin_amdgcn_s_getreg((3 << 11) | 20) & 0xFu; }
#define XB_SPIN(cond, bar) do { unsigned _sp = 0; while (cond) { __builtin_amdgcn_s_sleep(1); \
    if ((++_sp & 255u) == 0u) { if (xb_ld(&(bar)[XB_TMO])) break; if (_sp > XB_SPIN_CAP) { atomicAdd(&(bar)[XB_TMO], 1u); break; } } } } while (0)
struct XcdBarrier { unsigned* bar; unsigned x; volatile LAS unsigned* st; };
__device__ __forceinline__ XcdBarrier xcd_barrier_post(unsigned* bar, volatile LAS unsigned* st) {
    XcdBarrier b; b.bar = bar; b.x = xb_xcc_id(); b.st = st;
    if (threadIdx.x == 0) (void)xb_add(&bar[XB_XCNT(b.x)], 1u);
    return b;
}
__device__ __forceinline__ void xcd_barrier_complete(unsigned* bar, unsigned x, unsigned& nloc, unsigned& nx) {
    const unsigned G = gridDim.x * gridDim.y * gridDim.z;
    unsigned sum, cnt, mine, sp = 0u;
    for (;;) {
        sum = 0u; cnt = 0u; mine = 0u;
#pragma unroll
        for (unsigned j = 0; j < 16; ++j) { const unsigned c = xb_ld(&bar[XB_XCNT(j)]); sum += c; cnt += (c > 0u) ? 1u : 0u; mine = (j == x) ? c : mine; }
        if (sum == G) break;
        __builtin_amdgcn_s_sleep(1);
        if ((++sp & 255u) == 0u) { if (xb_ld(&bar[XB_TMO])) break; if (sp > XB_SPIN_CAP) { atomicAdd(&bar[XB_TMO], 1u); break; } }
    }
    nloc = mine > 0u ? mine : 1u; nx = cnt > 0u ? cnt : 1u;
}
__device__ __forceinline__ void xcd_barrier(const XcdBarrier& b) {
    asm volatile("s_waitcnt vmcnt(0)" ::: "memory");
    __syncthreads();
    if (threadIdx.x == 0) {
        unsigned* bar = b.bar;
        __builtin_amdgcn_s_waitcnt(0);
        unsigned nloc = b.st[0], nx = b.st[1];
        if (nloc == 0u) { xcd_barrier_complete(bar, b.x, nloc, nx); b.st[0] = nloc; b.st[1] = nx; }
        const unsigned old = xb_add(&bar[XB_XSUB(b.x)], 1u);
        const unsigned gen = old / nloc;
        if (old + 1u == (gen + 1u) * nloc) {
            __builtin_amdgcn_fence(__ATOMIC_RELEASE, "agent");
            asm volatile("s_waitcnt vmcnt(0)" ::: "memory");
            const unsigned og = xb_add(&bar[XB_TOP], 1u);
            const unsigned tg = og / nx;
            if (og + 1u == (tg + 1u) * nx) xb_add(&bar[XB_TOPGEN], 1u);
            else XB_SPIN(xb_ld(&bar[XB_TOPGEN]) == tg, bar);
            __builtin_amdgcn_fence(__ATOMIC_ACQUIRE, "agent");
            xb_add(&bar[XB_XGEN(b.x)], 1u);
            asm volatile("s_waitcnt vmcnt(0)" ::: "memory");
        } else {
            XB_SPIN(xb_ld(&bar[XB_XGEN(b.x)]) == gen, bar);
            __builtin_amdgcn_fence(__ATOMIC_ACQUIRE, "agent");
            asm volatile("s_waitcnt vmcnt(0)" ::: "memory");
        }
    }
    __syncthreads();
}

struct Params {
    const float* x; const int* pos; const float* gains; const float* a_w_in; const float* a_q_norm; const float* a_w_q_up; const float* a_kv_norm; const float* a_w_kv_up;
    const float* a_w_o; const float* b_kv_norm; const float* b_w_kv; const float* b_w_q; const float* b_w_o; const float* rel_bias; const float* ffn_w_in; const float* ffn_conv_w;
    const float* ffn_conv_b; const float* ffn_w_out; float* out; unsigned char* ws; int ph_lo, ph_hi;
};

struct WDesc { const float* src; const float* gain; bf16_t* dst; int K, Nsrc, Ndst, map; };
__device__ __forceinline__ int colmap(int map, int n) {
    if (map == 1) { if (n < 1024) return n; if (n >= NIN) return -1; const int j = n - 1024; return 1024 + (j >> 1) + (j & 1) * 32; }
    if (map == 2) { const int hh = n / DQK, w = n % DQK; if (w < 128) return n; const int j = w - 128; return hh * DQK + 128 + (j >> 1) + (j & 1) * 32; }
    return n;
}
__device__ __forceinline__ WDesc wdesc(const Params& p, int i) {
    WDesc w; bf16_t* ws = (bf16_t*)p.ws; w.gain = nullptr; w.map = 0;
    if (i < 2) { w.src = p.a_w_in + (size_t)i * D * NIN; w.gain = p.gains + (size_t)(i * 4 + 0) * D; w.dst = (bf16_t*)(p.ws + WS_WIN) + (size_t)i * NINP * D; w.K = D; w.Nsrc = NIN; w.Ndst = NINP; w.map = 1; }
    else if (i < 4) { const int l = i - 2; w.src = p.a_w_q_up + (size_t)l * QL * NQUP; w.gain = p.a_q_norm + l * QL; w.dst = (bf16_t*)(p.ws + WS_WUPG) + (size_t)l * 7168 * 512; w.K = QL; w.Nsrc = NQUP; w.Ndst = NQUP; w.map = 2; }
    else if (i < 6) { const int l = i - 4; w.src = p.a_w_kv_up + (size_t)l * KVL * NKVUP; w.gain = p.a_kv_norm + l * KVL; w.dst = (bf16_t*)(p.ws + WS_WUPG) + (size_t)l * 7168 * 512 + (size_t)NQUP * 512; w.K = KVL; w.Nsrc = NKVUP; w.Ndst = NKVUP; }
    else if (i < 10) { const int l = i - 6; w.src = (l < 2 ? p.a_w_o + (size_t)l * D * D : p.b_w_o + (size_t)(l - 2) * D * D); w.dst = (bf16_t*)(p.ws + WS_WO) + (size_t)l * D * D; w.K = D; w.Nsrc = D; w.Ndst = D; }
    else if (i == 10) { w.src = p.b_w_kv; w.gain = p.b_kv_norm; w.dst = (bf16_t*)(p.ws + WS_WKVQ); w.K = D; w.Nsrc = 4096; w.Ndst = 4096; }
    else if (i == 11) { w.src = p.b_w_q; w.gain = p.gains + (size_t)(2 * 4 + 0) * D; w.dst = (bf16_t*)(p.ws + WS_WKVQ) + (size_t)4096 * D; w.K = D; w.Nsrc = D; w.Ndst = D; }
    else if (i == 12) { w.src = p.b_w_q + (size_t)D * D; w.gain = p.gains + (size_t)(3 * 4 + 0) * D; w.dst = (bf16_t*)(p.ws + WS_WQ1); w.K = D; w.Nsrc = D; w.Ndst = D; }
    else if (i < 17) { const int l = i - 13; w.src = p.ffn_w_in + (size_t)l * D * FF2; w.gain = p.gains + (size_t)(l * 4 + 2) * D; w.dst = (bf16_t*)(p.ws + WS_WUP) + (size_t)l * FF2 * D; w.K = D; w.Nsrc = FF2; w.Ndst = FF2; }
    else { const int l = i - 17; w.src = p.ffn_w_out + (size_t)l * FF * D; w.dst = (bf16_t*)(p.ws + WS_WDN) + (size_t)l * D * FF; w.K = FF; w.Nsrc = D; w.Ndst = D; }
    (void)ws; return w;
}
constexpr int NWDESC = 21;
__device__ __forceinline__ void transpose_item(const WDesc& w, LAS float* scr, int item, int lane) {
    const int nblk = w.Ndst / 64, kb = item / nblk, nb = item % nblk, k0 = 64 * kb, n0 = 64 * nb;
    const int nl = (lane & 15) * 4, kr = lane >> 4;
    const int s0 = colmap(w.map, n0 + nl), s1 = colmap(w.map, n0 + nl + 1), s2 = colmap(w.map, n0 + nl + 2), s3 = colmap(w.map, n0 + nl + 3);
    const bool vec = (s0 >= 0) && (s1 == s0 + 1) && (s2 == s0 + 2) && (s3 == s0 + 3);
    f32x4 v[16];
    if (vec) {
#pragma unroll
        for (int i = 0; i < 16; ++i) v[i] = *(const f32x4*)(w.src + (size_t)(k0 + 4 * i + kr) * w.Nsrc + s0);
    } else {
#pragma unroll
        for (int i = 0; i < 16; ++i) { const float* r = w.src + (size_t)(k0 + 4 * i + kr) * w.Nsrc;
            v[i] = (f32x4){s0 >= 0 ? r[s0] : 0.f, s1 >= 0 ? r[s1] : 0.f, s2 >= 0 ? r[s2] : 0.f, s3 >= 0 ? r[s3] : 0.f}; }
    }
    if (w.gain) {
#pragma unroll
        for (int i = 0; i < 16; ++i) v[i] = v[i] * w.gain[k0 + 4 * i + kr];
    }
#pragma unroll
    for (int i = 0; i < 16; ++i) { LAS float* d = scr + (4 * i + kr) * 65 + nl; d[0] = v[i][0]; d[1] = v[i][1]; d[2] = v[i][2]; d[3] = v[i][3]; }
    LDS_WAIT(); asm volatile("" ::: "memory");
    const int c = lane & 7;
#pragma unroll
    for (int j = 0; j < 8; ++j) { const int n = (lane >> 3) + 8 * j; const LAS float* sp = scr + (8 * c) * 65 + n;
        u32x4 o; o.x = cvt_pk_bf16(sp[0 * 65], sp[1 * 65]); o.y = cvt_pk_bf16(sp[2 * 65], sp[3 * 65]); o.z = cvt_pk_bf16(sp[4 * 65], sp[5 * 65]); o.w = cvt_pk_bf16(sp[6 * 65], sp[7 * 65]);
        *(u32x4*)(w.dst + (size_t)(n0 + n) * w.K + k0 + 8 * c) = o; }
    LDS_WAIT(); asm volatile("" ::: "memory");
}
__device__ __forceinline__ void prologue_phase(const Params& p, LAS unsigned char* lds, int vcu, int G, int wave, int lane) {
    LAS float* scr = (LAS float*)(lds + wave * 16640);
    const int gw = vcu * NWAVES + wave, NGW = G * NWAVES;
    int start = gw;
    for (int d = 0; d < NWDESC; ++d) { const WDesc w = wdesc(p, d); const int n = (w.K / 64) * (w.Ndst / 64);
        int it = start; for (; it < n; it += NGW) transpose_item(w, scr, it, lane);
        start = it - n; }
    bf16_t* HB = (bf16_t*)(p.ws + WS_HB); float* RSH = (float*)(p.ws + WS_RSH);
    for (int row = gw; row < S; row += NGW) { const float* xr = p.x + (size_t)row * D; float ss = 0.f;
#pragma unroll
        for (int j = 0; j < 4; ++j) { const f32x4 a = *(const f32x4*)(xr + j * 512 + lane * 8), b = *(const f32x4*)(xr + j * 512 + lane * 8 + 4);
            ss += sumsq8(a, b, 1.f); *(u32x4*)(HB + (size_t)row * D + j * 512 + lane * 8) = pack8s(a, b, 1.f); }
        ss = wave_sum(ss); if (lane == 0) RSH[row] = rsqrtf(ss * (1.0f / D) + EPS); }
    { float* RC = (float*)(p.ws + WS_RCOS); float* RS = (float*)(p.ws + WS_RSIN);
      for (int i = gw * 64 + lane; i < S * 32; i += NGW * 64) { const int row = i >> 5, k = i & 31;
          const float inv = exp2f(-(float)k * (13.287712379549449f / 32.0f)); const float ang = (float)p.pos[row] * inv;
          const float kq = rintf(ang * 0.15915494309189535f); float r = fmaf(-kq, 6.28125f, ang); r = fmaf(-kq, 1.9353071795864769e-3f, r);
          const float rev = r * 0.15915494309189535f; RC[i] = __builtin_amdgcn_cosf(rev); RS[i] = __builtin_amdgcn_sinf(rev); } }
    float* KM = (float*)(p.ws + WS_KMEAN);
    for (int i = gw * 64 + lane; i < 32 * D; i += NGW * 64) KM[i] = 0.f;
}

__device__ __forceinline__ void resid_phase(const Params& p, const float* hin, const float* gain, int vcu, int G, int wave, int lane) {
    const int gw = vcu * NWAVES + wave, NGW = G * NWAVES;
    const bf16_t* MIX = (const bf16_t*)(p.ws + WS_MIX); const float* SSM = (const float*)(p.ws + WS_SSM);
    bf16_t* HB = (bf16_t*)(p.ws + WS_HB); float* RSH = (float*)(p.ws + WS_RSH);
    for (int row = gw; row < S; row += NGW) {
        float sv = (lane < 32) ? SSM[(size_t)row * 32 + lane] : 0.f; sv = wave_sum(sv);
        const float rs = rsqrtf(sv * (1.0f / D) + EPS); float ss = 0.f;
#pragma unroll
        for (int j = 0; j < 4; ++j) { const int col = j * 512 + lane * 8;
            const u32x4 mw = *(const u32x4*)(MIX + (size_t)row * D + col);
            const f32x4 h0 = *(const f32x4*)(hin + (size_t)row * D + col), h1 = *(const f32x4*)(hin + (size_t)row * D + col + 4);
            const f32x4 g0 = *(const f32x4*)(gain + col), g1 = *(const f32x4*)(gain + col + 4);
            f32x4 a, b;
            a[0] = h0[0] + bflo(mw.x) * rs * g0[0]; a[1] = h0[1] + bfhi(mw.x) * rs * g0[1]; a[2] = h0[2] + bflo(mw.y) * rs * g0[2]; a[3] = h0[3] + bfhi(mw.y) * rs * g0[3];
            b[0] = h1[0] + bflo(mw.z) * rs * g1[0]; b[1] = h1[1] + bfhi(mw.z) * rs * g1[1]; b[2] = h1[2] + bflo(mw.w) * rs * g1[2]; b[3] = h1[3] + bfhi(mw.w) * rs * g1[3];
            *(f32x4*)(p.out + (size_t)row * D + col) = a; *(f32x4*)(p.out + (size_t)row * D + col + 4) = b;
            *(u32x4*)(HB + (size_t)row * D + col) = pack8s(a, b, 1.f); ss += sumsq8(a, b, 1.f); }
        ss = wave_sum(ss); if (lane == 0) RSH[row] = rsqrtf(ss * (1.0f / D) + EPS); }
}
__device__ __forceinline__ float gelu_tanh(float x) {
    const float y = 0.7978845608028654f * (x + 0.044715f * x * x * x);
    const float e = __builtin_amdgcn_exp2f(y * 2.8853900817779268f);
    const float t = 1.0f - 2.0f * __builtin_amdgcn_rcpf(1.0f + e);
    return 0.5f * x * (1.0f + t);
}
__device__ __forceinline__ void convglu_phase(const Params& p, int layer, int vcu, int G, int tid) {
    const bf16_t* U = (const bf16_t*)(p.ws + WS_U); bf16_t* ACT = (bf16_t*)(p.ws + WS_ACT);
    const float* cw = p.ffn_conv_w + (size_t)layer * 3 * FF2; const float* cb = p.ffn_conv_b + (size_t)layer * FF2;
    constexpr int NCH = FF / 8, NTASK = (S / 16) * NCH;
    for (int task = vcu * 512 + tid; task < NTASK; task += G * 512) {
        const int ch = task % NCH, strip = task / NCH, c = ch * 8, s0 = strip * 16;
        float wg[3][8], wu[3][8], bg[8], bu[8];
#pragma unroll
        for (int j = 0; j < 3; ++j) { const f32x4 a = *(const f32x4*)(cw + (size_t)j * FF2 + c), b = *(const f32x4*)(cw + (size_t)j * FF2 + c + 4), cc = *(const f32x4*)(cw + (size_t)j * FF2 + FF + c), d = *(const f32x4*)(cw + (size_t)j * FF2 + FF + c + 4);
#pragma unroll
            for (int e = 0; e < 4; ++e) { wg[j][e] = a[e]; wg[j][4 + e] = b[e]; wu[j][e] = cc[e]; wu[j][4 + e] = d[e]; } }
        { const f32x4 a = *(const f32x4*)(cb + c), b = *(const f32x4*)(cb + c + 4), cc = *(const f32x4*)(cb + FF + c), d = *(const f32x4*)(cb + FF + c + 4);
#pragma unroll
          for (int e = 0; e < 4; ++e) { bg[e] = a[e]; bg[4 + e] = b[e]; bu[e] = cc[e]; bu[4 + e] = d[e]; } }
        float g2[8], g1[8], u2[8], u1[8];
#define LD8(dst, ptr) do { const u32x4 w_ = *(const u32x4*)(ptr); dst[0] = bflo(w_.x); dst[1] = bfhi(w_.x); dst[2] = bflo(w_.y); dst[3] = bfhi(w_.y); dst[4] = bflo(w_.z); dst[5] = bfhi(w_.z); dst[6] = bflo(w_.w); dst[7] = bfhi(w_.w); } while (0)
        if (s0 >= 2) { LD8(g2, U + (size_t)(s0 - 2) * FF2 + c); LD8(g1, U + (size_t)(s0 - 1) * FF2 + c); LD8(u2, U + (size_t)(s0 - 2) * FF2 + FF + c); LD8(u1, U + (size_t)(s0 - 1) * FF2 + FF + c); }
        else {
#pragma unroll
            for (int e = 0; e < 8; ++e) { g2[e] = 0.f; g1[e] = 0.f; u2[e] = 0.f; u1[e] = 0.f; } }
#pragma unroll 4
        for (int r = 0; r < 16; ++r) { float g0[8], u0[8]; LD8(g0, U + (size_t)(s0 + r) * FF2 + c); LD8(u0, U + (size_t)(s0 + r) * FF2 + FF + c);
            float o[8];
#pragma unroll
            for (int e = 0; e < 8; ++e) { const float gt = wg[0][e] * g2[e] + wg[1][e] * g1[e] + wg[2][e] * g0[e] + bg[e]; const float up = wu[0][e] * u2[e] + wu[1][e] * u1[e] + wu[2][e] * u0[e] + bu[e];
                o[e] = gelu_tanh(gt) * up; g2[e] = g1[e]; g1[e] = g0[e]; u2[e] = u1[e]; u1[e] = u0[e]; }
            u32x4 w; w.x = cvt_pk_bf16(o[0], o[1]); w.y = cvt_pk_bf16(o[2], o[3]); w.z = cvt_pk_bf16(o[4], o[5]); w.w = cvt_pk_bf16(o[6], o[7]);
            *(u32x4*)(ACT + (size_t)(s0 + r) * FF + c) = w; }
#undef LD8
    }
}
__device__ __forceinline__ void gate_phase(const Params& p, LAS unsigned char* lds, int vcu, int G, int tid) {
    const bf16_t* Q = (const bf16_t*)(p.ws + WS_Q); const float* KM = (const float*)(p.ws + WS_KMEAN); unsigned* SEL = (unsigned*)(p.ws + WS_SEL);
    LAS float* km = (LAS float*)lds;
    for (int unit = vcu; unit < NH * 16; unit += G) {
        const int h = unit >> 4, qc = unit & 15;
        __syncthreads();
        for (int i = tid; i < 32 * 128; i += 512) km[i] = KM[(size_t)(i >> 7) * D + h * 128 + (i & 127)] * (1.0f / 256.0f);
        __syncthreads();
        const int q = qc * 512 + tid, own = q >> 8;
        float acc[32];
#pragma unroll
        for (int g = 0; g < 4; ++g) { float a8[8];
#pragma unroll
            for (int j = 0; j < 8; ++j) a8[j] = 0.f;
#pragma unroll 1
            for (int d = 0; d < 128; d += 8) { const u32x4 qw = *(const u32x4*)(Q + (size_t)q * D + h * 128 + d);
                const float q0 = bflo(qw.x), q1 = bfhi(qw.x), q2 = bflo(qw.y), q3 = bfhi(qw.y), q4 = bflo(qw.z), q5 = bfhi(qw.z), q6 = bflo(qw.w), q7 = bfhi(qw.w);
#pragma unroll
                for (int j = 0; j < 8; ++j) { const f32x4 k0 = *(const LAS f32x4*)(km + (g * 8 + j) * 128 + d), k1 = *(const LAS f32x4*)(km + (g * 8 + j) * 128 + d + 4);
                    a8[j] += (q0 * k0[0] + q1 * k0[1]) + (q2 * k0[2] + q3 * k0[3]) + (q4 * k1[0] + q5 * k1[1]) + (q6 * k1[2] + q7 * k1[3]); } }
#pragma unroll
            for (int j = 0; j < 8; ++j) acc[g * 8 + j] = a8[j]; }
        unsigned mask = 0u; const int cnt = own < 3 ? own : 3;
#pragma unroll
        for (int k = 0; k < 3; ++k) { if (k < cnt) { float best = -__builtin_inff(); int bi = 0;
#pragma unroll
                for (int n = 0; n < 32; ++n) { const bool ok = (n < own) && !((mask >> n) & 1u) && (acc[n] > best); if (ok) { best = acc[n]; bi = n; } }
                mask |= 1u << bi; } }
        SEL[(size_t)q * NH + h] = mask | (1u << own);
    }
}

__global__ void __launch_bounds__(NWAVES * 64, 2) fwd_kernel(Params p) {
    extern __shared__ __attribute__((aligned(16))) unsigned char lds_raw[];
    LAS unsigned char* lds = (LAS unsigned char*)lds_raw;
    const int tid = threadIdx.x, lane = tid & 63, wave = __builtin_amdgcn_readfirstlane(tid >> 6);
    const int G = gridDim.x; const int bx = blockIdx.x; const int vcu = (G % 8 == 0) ? (bx % 8) * (G / 8) + bx / 8 : bx;
    volatile LAS unsigned* MISC = (volatile LAS unsigned*)(lds + MISC_OFF);
    for (int u = tid; u < (LDS_BYTES - LDSCTL_OFF) / 4; u += NWAVES * 64) ((LAS unsigned*)(lds + LDSCTL_OFF))[u] = 0u;
    __syncthreads();
    unsigned* ctl = (unsigned*)(p.ws + WS_CTL);
    XcdBarrier bar; bar.bar = ctl + CW_BAR; bar.x = 0; bar.st = nullptr;
    const bool one_launch = (p.ph_hi - p.ph_lo) > 1;
    if (one_launch) bar = xcd_barrier_post(ctl + CW_BAR, MISC + 8);
    const int lo = p.ph_lo, hi = p.ph_hi;
    int ph = 0;
#define IN() (lo <= ph && ph < hi)
#define SEAM() do { if (ph + 1 < hi) xcd_barrier(bar); } while (0)

    bf16_t* HB = (bf16_t*)(p.ws + WS_HB); float* RSH = (float*)(p.ws + WS_RSH);
    bf16_t* CQ = (bf16_t*)(p.ws + WS_CQ); bf16_t* CKV = (bf16_t*)(p.ws + WS_CKV); bf16_t* KROPE = (bf16_t*)(p.ws + WS_KROPE); float* SSQ = (float*)(p.ws + WS_SSQ);
    bf16_t* Qb = (bf16_t*)(p.ws + WS_Q); bf16_t* KN = (bf16_t*)(p.ws + WS_KN); bf16_t* Vb = (bf16_t*)(p.ws + WS_V);
    bf16_t* KB = (bf16_t*)(p.ws + WS_KB); bf16_t* VB = (bf16_t*)(p.ws + WS_VB); float* KMEAN = (float*)(p.ws + WS_KMEAN);
    bf16_t* Ob = (bf16_t*)(p.ws + WS_O); bf16_t* MIX = (bf16_t*)(p.ws + WS_MIX); float* SSM = (float*)(p.ws + WS_SSM);
    bf16_t* Ub = (bf16_t*)(p.ws + WS_U); bf16_t* ACT = (bf16_t*)(p.ws + WS_ACT);
    const float* RCOS = (const float*)(p.ws + WS_RCOS); const float* RSIN = (const float*)(p.ws + WS_RSIN);

    if (SITE(0) && IN()) { REPS(0) { { const int t_ = opaque_tid(); prologue_phase(p, lds, vcu, G, __builtin_amdgcn_readfirstlane(t_ >> 6), t_ & 63); } } SEAM(); } ++ph;

    for (int layer = 0; layer < NLAYER; ++layer) {
        if (layer < 2) {
            if (SITE(1) && IN()) { REPS(1) { pg8::Sched Sc; Sc.init(S, D, HB, (const bf16_t*)(p.ws + WS_WIN) + (size_t)layer * NINP * D, NINP, nullptr, nullptr, 0, G, bx);
                EpiMlaIn E{CQ, CKV, KROPE, SSQ, RSH, RCOS, RSIN};
                pg8::gemm_phase<EpiMlaIn, true, true>(lds, D, Sc, E); } SEAM(); } ++ph;
            if (SITE(2) && IN()) { REPS(2) { const bf16_t* W = (const bf16_t*)(p.ws + WS_WUPG) + (size_t)layer * 7168 * 512;
                pg8::Sched Sc; Sc.init(S, 512, CQ, W, NQUP, CKV, W + (size_t)NQUP * 512, NKVUP, G, bx);
                EpiMlaUp E{Qb, KN, Vb, SSQ, RCOS, RSIN};
                pg8::gemm_phase<EpiMlaUp, true, true>(lds, 512, Sc, E); } SEAM(); } ++ph;
            if (SITE(3) && IN()) { REPS(3) { att::Args T{Qb, KN, KROPE, Vb, Ob, nullptr, nullptr, p.pos};
                for (int it = vcu; it < NH * 16; it += G) { const int h = it >> 4, y = it & 15;
                    att::attn_unit<false>(lds, T, h, y); att::attn_unit<false>(lds, T, h, 31 - y); }
                } SEAM(); } ++ph;
        } else {
            if (SITE(4) && IN()) { REPS(4) { const bool first = (layer == 2);
                pg8::Sched Sc; Sc.init(S, D, HB, first ? (const bf16_t*)(p.ws + WS_WKVQ) : (const bf16_t*)(p.ws + WS_WQ1), first ? 6144 : 2048, nullptr, nullptr, 0, G, bx);
                EpiMobaKvq E{p.ws, KMEAN, RSH, first ? 0 : 16};
                pg8::gemm_phase<EpiMobaKvq, true, true>(lds, D, Sc, E); } SEAM(); } ++ph;
            if (SITE(5) && IN()) { REPS(5) { gate_phase(p, lds, vcu, G, opaque_tid()); } SEAM(); } ++ph;
            if (SITE(6) && IN()) { REPS(6) { att::Args T{Qb, KB, nullptr, VB, Ob, (const unsigned*)(p.ws + WS_SEL), p.rel_bias, p.pos};
                for (int it = vcu; it < NH * 16; it += G) { const int h = it >> 4, y = it & 15;
                    att::attn_unit<true>(lds, T, h, y); att::attn_unit<true>(lds, T, h, 31 - y); }
                } SEAM(); } ++ph;
        }
        if (SITE(7) && IN()) { REPS(7) { pg8::Sched Sc; Sc.init(S, D, Ob, (const bf16_t*)(p.ws + WS_WO) + (size_t)layer * D * D, D, nullptr, nullptr, 0, G, bx);
            EpiMix E{MIX, SSM};
            pg8::gemm_phase<EpiMix, false, true>(lds, D, Sc, E); } SEAM(); } ++ph;
        if (SITE(8) && IN()) { REPS(8) { { const int t_ = opaque_tid(); resid_phase(p, layer == 0 ? p.x : p.out, p.gains + (size_t)(layer * 4 + 1) * D, vcu, G, __builtin_amdgcn_readfirstlane(t_ >> 6), t_ & 63); } } SEAM(); } ++ph;
        if (SITE(9) && IN()) { REPS(9) { pg8::Sched Sc; Sc.init(S, D, HB, (const bf16_t*)(p.ws + WS_WUP) + (size_t)layer * FF2 * D, FF2, nullptr, nullptr, 0, G, bx);
            EpiFfnUp E{Ub, RSH};
            pg8::gemm_phase<EpiFfnUp, true, true>(lds, D, Sc, E); } SEAM(); } ++ph;
        if (SITE(10) && IN()) { REPS(10) { convglu_phase(p, layer, vcu, G, opaque_tid()); } SEAM(); } ++ph;
        if (SITE(11) && IN()) { REPS(11) { pg8::Sched Sc; Sc.init(S, FF, ACT, (const bf16_t*)(p.ws + WS_WDN) + (size_t)layer * D * FF, D, nullptr, nullptr, 0, G, bx);
            EpiMix E{MIX, SSM};
            pg8::gemm_phase<EpiMix, false, true>(lds, FF, Sc, E); } SEAM(); } ++ph;
        if (SITE(12) && IN()) { REPS(12) { { const int t_ = opaque_tid(); resid_phase(p, p.out, p.gains + (size_t)(layer * 4 + 3) * D, vcu, G, __builtin_amdgcn_readfirstlane(t_ >> 6), t_ & 63); } } SEAM(); } ++ph;
    }
#undef IN
#undef SEAM
}

extern "C" void kernel_launch(void* const* d_in, const int* in_sizes, int n_in, void* d_out, int out_size, void* d_ws, size_t ws_size, hipStream_t stream) {
    static int grid = 0;
    if (grid == 0) {
        if (n_in != 18 || in_sizes[0] != S * D || out_size != S * D || ws_size < WS_END) { fprintf(stderr, "kernel_launch: unexpected shapes (n_in %d, in0 %d, out %d, ws %zu)\n", n_in, n_in > 0 ? in_sizes[0] : -1, out_size, ws_size); grid = -1; return; }
        int dev = 0, cus = 0, per_cu = 0;
        if (hipGetDevice(&dev) != hipSuccess || hipDeviceGetAttribute(&cus, hipDeviceAttributeMultiprocessorCount, dev) != hipSuccess) { grid = -1; return; }
        if (hipFuncSetAttribute((const void*)fwd_kernel, hipFuncAttributeMaxDynamicSharedMemorySize, LDS_BYTES) != hipSuccess) { fprintf(stderr, "kernel_launch: hipFuncSetAttribute failed\n"); grid = -1; return; }
        if (hipOccupancyMaxActiveBlocksPerMultiprocessor(&per_cu, (const void*)fwd_kernel, NWAVES * 64, LDS_BYTES) != hipSuccess || per_cu < 1) fprintf(stderr, "kernel_launch: occupancy query reports %d\n", per_cu);
        (void)hipGetLastError();
        grid = cus;
    }
    if (grid < 0) return;
    (void)hipMemsetAsync((char*)d_ws + WS_CTL, 0, CTL_ZERO_BYTES, stream);
    Params p{};
    p.x = (const float*)d_in[0]; p.pos = (const int*)d_in[1]; p.gains = (const float*)d_in[2]; p.a_w_in = (const float*)d_in[3]; p.a_q_norm = (const float*)d_in[4];
    p.a_w_q_up = (const float*)d_in[5]; p.a_kv_norm = (const float*)d_in[6]; p.a_w_kv_up = (const float*)d_in[7]; p.a_w_o = (const float*)d_in[8]; p.b_kv_norm = (const float*)d_in[9];
    p.b_w_kv = (const float*)d_in[10]; p.b_w_q = (const float*)d_in[11]; p.b_w_o = (const float*)d_in[12]; p.rel_bias = (const float*)d_in[13]; p.ffn_w_in = (const float*)d_in[14];
    p.ffn_conv_w = (const float*)d_in[15]; p.ffn_conv_b = (const float*)d_in[16]; p.ffn_w_out = (const float*)d_in[17]; p.out = (float*)d_out; p.ws = (unsigned char*)d_ws;
#if MK_ONE_LAUNCH
    p.ph_lo = 0; p.ph_hi = NPHASE;
    hipLaunchKernelGGL(fwd_kernel, dim3(grid), dim3(NWAVES * 64), LDS_BYTES, stream, p);
#else
    for (int ph = 0; ph < NPHASE; ++ph) { p.ph_lo = ph; p.ph_hi = ph + 1;
        hipLaunchKernelGGL(fwd_kernel, dim3(grid), dim3(NWAVES * 64), LDS_BYTES, stream, p); }
#endif
}
```

```cpp
#include <hip/hip_runtime.h>
#include <cstdio>
#include <cstdint>

#ifndef MK_ONE_LAUNCH
#define MK_ONE_LAUNCH 1
#endif

#ifndef SITE_MASK
#define SITE_MASK 0xFFFF
#endif
#define SITE(n) (((SITE_MASK) >> (n)) & 1)
#ifndef REP_SITE
#define REP_SITE -1
#endif
#ifndef REP_N
#define REP_N 1
#endif
#define REPS(n) for (int rep_ = 0; rep_ < ((n) == (REP_SITE) ? (REP_N) : 1); ++rep_)
#define LAS __attribute__((address_space(3)))
#define GAS __attribute__((address_space(1)))
typedef unsigned short bf16_t;
typedef short bf16x8 __attribute__((ext_vector_type(8)));
typedef short s16x4 __attribute__((ext_vector_type(4)));
typedef float f32x2 __attribute__((ext_vector_type(2)));
typedef float f32x4 __attribute__((ext_vector_type(4)));
typedef float f32x16 __attribute__((ext_vector_type(16)));
typedef unsigned u32x2 __attribute__((ext_vector_type(2)));
typedef unsigned u32x4 __attribute__((ext_vector_type(4)));
typedef int i32x4 __attribute__((ext_vector_type(4)));
typedef GAS unsigned gu32;

constexpr int S = 8192, D = 2048, NH = 16, FF = 5632, FF2 = 11264;
constexpr int QL = 512, KVL = 512, DQK = 192;
constexpr int NIN = 1088, NINP = 1280;
constexpr int NQUP = NH * DQK, NKVUP = NH * 256;
constexpr int NLAYER = 4;
constexpr float EPS = 1e-6f;
constexpr int NPHASE = 1 + NLAYER * 8;

constexpr size_t MiB = 1u << 20;
constexpr size_t WS_CTL = 0, CTL_ZERO_BYTES = 1 * MiB;
constexpr size_t WS_WIN = 2 * MiB;
constexpr size_t WS_WUPG = 12 * MiB;
constexpr size_t WS_WO = 26 * MiB;
constexpr size_t WS_WKVQ = 58 * MiB;
constexpr size_t WS_WQ1 = 82 * MiB;
constexpr size_t WS_WUP = 90 * MiB;
constexpr size_t WS_WDN = 266 * MiB;
constexpr size_t WS_HB = 354 * MiB;
constexpr size_t WS_RSH = 386 * MiB;
constexpr size_t WS_CQ = 387 * MiB;
constexpr size_t WS_CKV = 395 * MiB;
constexpr size_t WS_KROPE = 403 * MiB;
constexpr size_t WS_SSQ = 404 * MiB;
constexpr size_t WS_Q = 405 * MiB;
constexpr size_t WS_KN = 453 * MiB;
constexpr size_t WS_V = 485 * MiB;
constexpr size_t WS_KB = 517 * MiB;
constexpr size_t WS_VB = 549 * MiB;
constexpr size_t WS_KMEAN = 581 * MiB;
constexpr size_t WS_SEL = 582 * MiB;
constexpr size_t WS_O = 583 * MiB;
constexpr size_t WS_MIX = 615 * MiB;
constexpr size_t WS_SSM = 647 * MiB;
constexpr size_t WS_U = 648 * MiB;
constexpr size_t WS_ACT = 824 * MiB;
constexpr size_t WS_RCOS = 912 * MiB;
constexpr size_t WS_RSIN = 913 * MiB;
constexpr size_t WS_END = 914 * MiB;

constexpr int CW_BAR = 4096;

constexpr int RING_BYTES = 131072;
constexpr int LDSCTL_OFF = 139264, MISC_OFF = LDSCTL_OFF + 320;
constexpr int LDS_BYTES = 147456;
constexpr int NWAVES = 8;

#define LDS_WAIT() asm volatile("s_waitcnt lgkmcnt(0)" ::: "memory")
#define VM_WAIT() asm volatile("s_waitcnt vmcnt(0)" ::: "memory")
#define SBAR() __builtin_amdgcn_sched_barrier(0)

__device__ __forceinline__ int opaque_tid() { int t = threadIdx.x; asm volatile("" : "+v"(t)); return t; }
__device__ __forceinline__ unsigned cvt_pk_bf16(float lo, float hi) { unsigned r; asm volatile("v_cvt_pk_bf16_f32 %0, %1, %2" : "=v"(r) : "v"(lo), "v"(hi)); return r; }
__device__ __forceinline__ float bf2f(unsigned short b) { return __uint_as_float(((unsigned)b) << 16); }
__device__ __forceinline__ float bflo(unsigned w) { return __uint_as_float(w << 16); }
__device__ __forceinline__ float bfhi(unsigned w) { return __uint_as_float(w & 0xffff0000u); }
__device__ __forceinline__ float wave_sum(float v) {
#pragma unroll
    for (int o = 1; o < 64; o <<= 1) v += __shfl_xor(v, o);
    return v;
}

namespace pg8 {
constexpr int BM = 256, BK = 64, HALF = 128, HTB = HALF * BK * 2, STAGE_BYTES = 8 * HTB, NXCD = 8, WGM = 8;
__host__ __device__ __forceinline__ int lds_byte(int r, int c) { const int st = (r >> 4) * 2 + (c >> 5), rr = r & 15, cc = c & 31, ob = rr * 64 + cc * 2; return st * 1024 + (ob ^ (((ob >> 9) & 1) << 5)); }
__host__ __device__ __forceinline__ void stage_rc(int b, int& R, int& C) { const int st = b / 1024, sb = b % 1024, swz = sb ^ (((sb >> 9) & 1) << 5); R = (st >> 1) * 16 + swz / 64; C = (st & 1) * 32 + (swz % 64) / 2; }
__host__ __device__ __forceinline__ int perm32(int rho) { const int n = rho >> 4, i = rho & 15; return 8 * (i >> 2) + 4 * n + (i & 3); }

struct Unit { int pm, pn, gi; };

struct Sched {
    int nM, nN0, nwg0, nN1, nwg1, G, c;
    const char* A0; const char* B0; const char* A1; const char* B1; size_t tstep; long astep, aoff;
    __device__ __forceinline__ void init(int M, int K, const bf16_t* a0, const bf16_t* b0, int N0, const bf16_t* a1, const bf16_t* b1, int N1, int G_, int c_, int mstep = BM, int moff = 0) {
        nM = (M - moff + mstep - 1) / mstep; nN0 = N0 / BM; nwg0 = nM * nN0; nN1 = N1 / BM; nwg1 = nM * nN1; G = G_; c = c_;
        A0 = (const char*)a0; B0 = (const char*)b0; A1 = (const char*)a1; B1 = (const char*)b1; tstep = (size_t)BM * K * 2; astep = (long)mstep * K * 2; aoff = (long)moff * K * 2;
    }
    __device__ __forceinline__ void map(int wgid, int nwg, int nN, Unit& u) const {
        { const int q = nwg / NXCD, r = nwg % NXCD, xcd = wgid % NXCD, off = wgid / NXCD; wgid = (xcd < r ? xcd * (q + 1) : r * (q + 1) + (xcd - r) * q) + off; }
        const int nig = WGM * nN, gid = wgid / nig, fm = gid * WGM, gsz = (nM - fm) < WGM ? (nM - fm) : WGM;
        u.pm = fm + ((wgid % nig) % gsz); u.pn = (wgid % nig) / gsz;
    }
    __device__ __forceinline__ bool next(int i, Unit& u) const {
        const long L = (long)i * G + c;
        if (L < nwg0) { u.gi = 0; map((int)L, nwg0, nN0, u); return true; }
        if (L < nwg0 + nwg1) { u.gi = 1; map((int)(L - nwg0), nwg1, nN1, u); return true; }
        return false;
    }
    __device__ __forceinline__ const char* aptr(const Unit& u) const { return (u.gi ? A1 : A0) + ((long)u.pm * astep + aoff); }
    __device__ __forceinline__ const char* bptr(const Unit& u) const { return (u.gi ? B1 : B0) + (size_t)u.pn * tstep; }
};

template <class Epi, bool ALIGN_EPI, bool SP2, bool APERM = false>
__device__ __forceinline__ void gemm_phase(LAS unsigned char* lds, const int K, const Sched& S, const Epi& E) {
    const int tid = opaque_tid(), wid = __builtin_amdgcn_readfirstlane(tid >> 6), lane = tid & 63, wr = wid >> 2, wc = wid & 3, fr = lane & 15, fq = lane >> 4;
    const int nt = K / BK;
    unsigned voffA[2], voffB[2];
#pragma unroll
    for (int i = 0; i < 2; ++i) { int R, C; stage_rc(tid * 16 + i * 8192, R, C); const int Rb = Epi::PERM ? ((R & ~31) + perm32(R & 31)) : R;
        const int Ra = APERM ? (128 * (R >> 6) + (R & 63)) : R;
        voffA[i] = (unsigned)(Ra * K + C) * 2u; voffB[i] = (unsigned)(Rb * K + C) * 2u; }
    const size_t kstep = (size_t)(BK * 2);
    const size_t hstep = (size_t)HALF * K * 2, hstepA = APERM ? (size_t)64 * K * 2 : hstep;
    const unsigned ldsw = (unsigned)wid * 1024u;
    const int aoff = lds_byte(wr * 64 + fr, fq * 8), boff = lds_byte(wc * 32 + fr, fq * 8);
#define PG8_SA(b, h) (((b) * 2 + (h)) * HTB)
#define PG8_SB(b, h) ((4 + (b) * 2 + (h)) * HTB)
#define PG8_STAGE(bufoff, gbase, voff) do { _Pragma("unroll") for (int _i = 0; _i < 2; ++_i) \
        __builtin_amdgcn_global_load_lds((const unsigned*)((const char*)(gbase) + (voff)[_i]), (LAS unsigned*)(lds + (bufoff) + ldsw + _i * 8192), 16, 0, 0); } while (0)
#define PG8_LDA(dst, b, h) do { _Pragma("unroll") for (int m = 0; m < 4; ++m) _Pragma("unroll") for (int k = 0; k < 2; ++k) dst[m][k] = *(const LAS bf16x8*)(lds + PG8_SA(b, h) + aoff + m * 2048 + k * 1024); } while (0)
#define PG8_LDB(dst, b, h) do { _Pragma("unroll") for (int n = 0; n < 2; ++n) _Pragma("unroll") for (int k = 0; k < 2; ++k) dst[n][k] = *(const LAS bf16x8*)(lds + PG8_SB(b, h) + boff + n * 2048 + k * 1024); } while (0)
#define PG8_MMA(ai, bj, At, Bt) do { __builtin_amdgcn_s_setprio(1); _Pragma("unroll") for (int m = 0; m < 4; ++m) _Pragma("unroll") for (int n = 0; n < 2; ++n) _Pragma("unroll") for (int k = 0; k < 2; ++k) \
        acc[ai][bj][m][n] = __builtin_amdgcn_mfma_f32_16x16x32_bf16(Bt[n][k], At[m][k], acc[ai][bj][m][n], 0, 0, 0); __builtin_amdgcn_s_setprio(0); } while (0)
#define PG8_WAIT_V(n) asm volatile("s_waitcnt vmcnt(" #n ")" ::: "memory")
#define PG8_WAIT_L(n) asm volatile("s_waitcnt lgkmcnt(" #n ")" ::: "memory")
#define PG8_BAR __builtin_amdgcn_s_barrier()
#define PG8_SCHED __builtin_amdgcn_sched_barrier(0)
    Unit cur, nxt; int ui = 0;
    if (!S.next(0, cur)) return;
    f32x4 acc[2][2][4][2];
#pragma unroll
    for (int a = 0; a < 2; ++a)
#pragma unroll
        for (int b = 0; b < 2; ++b)
#pragma unroll
            for (int m = 0; m < 4; ++m)
#pragma unroll
                for (int n = 0; n < 2; ++n) acc[a][b][m][n] = (f32x4){0.f, 0.f, 0.f, 0.f};
    bf16x8 At[4][2], B0[2][2], B1[2][2];
    const char* cA = S.aptr(cur); const char* cB = S.bptr(cur);
    if constexpr (SP2) {
        PG8_STAGE(PG8_SB(0, 0), cB, voffB); PG8_STAGE(PG8_SB(0, 1), cB + hstep, voffB); PG8_STAGE(PG8_SA(0, 0), cA, voffA); PG8_STAGE(PG8_SA(0, 1), cA + hstepA, voffA);
        if (wr == 1) PG8_BAR;
        PG8_WAIT_V(2); PG8_BAR;
        PG8_STAGE(PG8_SB(1, 0), cB + kstep, voffB); PG8_STAGE(PG8_SA(1, 0), cA + kstep, voffA); PG8_STAGE(PG8_SB(1, 1), cB + hstep + kstep, voffB);
        PG8_WAIT_V(6); PG8_BAR;
    } else {
        PG8_STAGE(PG8_SB(0, 0), cB, voffB); PG8_STAGE(PG8_SA(0, 0), cA, voffA); PG8_STAGE(PG8_SB(0, 1), cB + hstep, voffB); PG8_STAGE(PG8_SA(0, 1), cA + hstepA, voffA);
        if (wr == 1) PG8_BAR;
        PG8_WAIT_V(4); PG8_BAR;
        PG8_STAGE(PG8_SB(1, 0), cB + kstep, voffB); PG8_STAGE(PG8_SA(1, 0), cA + kstep, voffA); PG8_STAGE(PG8_SB(1, 1), cB + hstep + kstep, voffB);
        PG8_WAIT_V(6); PG8_BAR;
    }
    for (;;) {
        const bool has_next = S.next(ui + 1, nxt);
        const char* nA = has_next ? S.aptr(nxt) : cA; const char* nB = has_next ? S.bptr(nxt) : cB;
        for (int t = 0; t < nt; t += 2) {
            const bool last = (t == nt - 2);
            const char* a1 = cA + (size_t)(t + 1) * kstep;
            const char* a2 = last ? nA : cA + (size_t)(t + 2) * kstep; const char* b2 = last ? nB : cB + (size_t)(t + 2) * kstep;
            const char* a3 = a2 + kstep; const char* b3 = b2 + kstep;
            if constexpr (SP2) {
            PG8_LDB(B0, 0, 0); PG8_LDB(B1, 0, 1); PG8_SCHED; PG8_LDA(At, 0, 0); PG8_STAGE(PG8_SA(1, 1), a1 + hstepA, voffA);
            PG8_WAIT_V(8); PG8_WAIT_L(0); PG8_BAR; PG8_MMA(0, 0, At, B0); PG8_MMA(0, 1, At, B1); PG8_BAR; PG8_SCHED;
            PG8_LDA(At, 0, 1); PG8_STAGE(PG8_SB(0, 0), b2, voffB); PG8_STAGE(PG8_SB(0, 1), b2 + hstep, voffB); PG8_STAGE(PG8_SA(0, 0), a2, voffA);
            PG8_WAIT_V(8); PG8_WAIT_L(0); PG8_BAR; PG8_MMA(1, 0, At, B0); PG8_MMA(1, 1, At, B1); PG8_BAR; PG8_SCHED;
            PG8_LDB(B0, 1, 0); PG8_LDB(B1, 1, 1); PG8_SCHED; PG8_LDA(At, 1, 0); PG8_STAGE(PG8_SA(0, 1), a2 + hstepA, voffA);
            PG8_WAIT_V(8); PG8_WAIT_L(0); PG8_BAR; PG8_MMA(0, 0, At, B0); PG8_MMA(0, 1, At, B1); PG8_BAR; PG8_SCHED;
            PG8_LDA(At, 1, 1); PG8_STAGE(PG8_SB(1, 0), b3, voffB); PG8_STAGE(PG8_SB(1, 1), b3 + hstep, voffB); PG8_STAGE(PG8_SA(1, 0), a3, voffA);
            PG8_WAIT_V(8); PG8_WAIT_L(0); PG8_BAR; PG8_MMA(1, 0, At, B0); PG8_MMA(1, 1, At, B1); PG8_BAR; PG8_SCHED;
            } else {
            PG8_LDB(B0, 0, 0); PG8_SCHED; PG8_LDA(At, 0, 0); PG8_STAGE(PG8_SA(1, 1), a1 + hstepA, voffA);
            PG8_WAIT_L(8); PG8_BAR; PG8_WAIT_L(0); PG8_MMA(0, 0, At, B0); PG8_BAR; PG8_SCHED;
            PG8_LDB(B1, 0, 1); PG8_STAGE(PG8_SB(0, 0), b2, voffB);
            PG8_BAR; PG8_WAIT_L(0); PG8_MMA(0, 1, At, B1); PG8_BAR;
            PG8_LDA(At, 0, 1); PG8_STAGE(PG8_SA(0, 0), a2, voffA);
            PG8_BAR; PG8_WAIT_L(0); PG8_MMA(1, 0, At, B0); PG8_BAR; PG8_SCHED;
            PG8_STAGE(PG8_SB(0, 1), b2 + hstep, voffB);
            PG8_WAIT_V(6); PG8_BAR; PG8_MMA(1, 1, At, B1); PG8_BAR;
            PG8_LDB(B0, 1, 0); PG8_SCHED; PG8_LDA(At, 1, 0); PG8_STAGE(PG8_SA(0, 1), a2 + hstepA, voffA);
            PG8_WAIT_L(8); PG8_BAR; PG8_WAIT_L(0); PG8_MMA(0, 0, At, B0); PG8_BAR; PG8_SCHED;
            PG8_LDB(B1, 1, 1); PG8_STAGE(PG8_SB(1, 0), b3, voffB);
            PG8_BAR; PG8_WAIT_L(0); PG8_MMA(0, 1, At, B1); PG8_BAR;
            PG8_LDA(At, 1, 1); PG8_STAGE(PG8_SA(1, 0), a3, voffA);
            PG8_BAR; PG8_WAIT_L(0); PG8_MMA(1, 0, At, B0); PG8_BAR; PG8_SCHED;
            PG8_STAGE(PG8_SB(1, 1), b3 + hstep, voffB);
            PG8_WAIT_V(6); PG8_BAR; PG8_MMA(1, 1, At, B1); PG8_BAR;
            }
        }
        if constexpr (ALIGN_EPI) { if (wr == 0) PG8_BAR; }
        E(acc, cur, wr, wc, fr, fq);
        if (!has_next) break;
#pragma unroll
        for (int a = 0; a < 2; ++a)
#pragma unroll
            for (int b = 0; b < 2; ++b)
#pragma unroll
                for (int m = 0; m < 4; ++m)
#pragma unroll
                    for (int n = 0; n < 2; ++n) acc[a][b][m][n] = (f32x4){0.f, 0.f, 0.f, 0.f};
        cur = nxt; cA = nA; cB = nB; ++ui;
        if constexpr (ALIGN_EPI) { if (wr == 1) PG8_BAR; }
    }
    PG8_WAIT_V(0);
    if constexpr (!ALIGN_EPI) { if (wr == 0) PG8_BAR; }
    PG8_BAR;
#undef PG8_SA
#undef PG8_SB
#undef PG8_STAGE
#undef PG8_LDA
#undef PG8_LDB
#undef PG8_MMA
#undef PG8_WAIT_V
#undef PG8_WAIT_L
#undef PG8_BAR
#undef PG8_SCHED
}
}

#define EPI_ROWS_BEGIN() const int row0 = u.pm * 256 + wr * 64 + fr; const int cl0 = wc * 32 + 8 * fq;
__device__ __forceinline__ u32x4 pack8s(f32x4 a, f32x4 b, float s) {
    u32x4 w; w.x = cvt_pk_bf16(a[0] * s, a[1] * s); w.y = cvt_pk_bf16(a[2] * s, a[3] * s); w.z = cvt_pk_bf16(b[0] * s, b[1] * s); w.w = cvt_pk_bf16(b[2] * s, b[3] * s); return w;
}
__device__ __forceinline__ float sumsq8(f32x4 a, f32x4 b, float s) {
    a = a * s; b = b * s; return (a[0] * a[0] + a[1] * a[1]) + (a[2] * a[2] + a[3] * a[3]) + (b[0] * b[0] + b[1] * b[1]) + (b[2] * b[2] + b[3] * b[3]);
}
__device__ __forceinline__ void rope8(f32x4& a, f32x4& b, const float* ctab, const float* stab, int row, int i0) {
    const f32x4 cs = *(const f32x4*)(ctab + (size_t)row * 32 + i0), sn = *(const f32x4*)(stab + (size_t)row * 32 + i0);
    const f32x4 a2 = (f32x4){a[0] * cs[0] - a[1] * sn[0], a[0] * sn[0] + a[1] * cs[0], a[2] * cs[1] - a[3] * sn[1], a[2] * sn[1] + a[3] * cs[1]};
    const f32x4 b2 = (f32x4){b[0] * cs[2] - b[1] * sn[2], b[0] * sn[2] + b[1] * cs[2], b[2] * cs[3] - b[3] * sn[3], b[2] * sn[3] + b[3] * cs[3]};
    a = a2; b = b2;
}

struct EpiMlaIn {
    static constexpr bool PERM = true;
    bf16_t* CQ; bf16_t* CKV; bf16_t* KR; float* SSQ; const float* rsh; const float* ctab; const float* stab;
    __device__ __forceinline__ void operator()(const f32x4 (&acc)[2][2][4][2], const pg8::Unit& u, int wr, int wc, int fr, int fq) const {
        EPI_ROWS_BEGIN();
        if (u.pn < 4) {
            bf16_t* base = (u.pn < 2 ? CQ : CKV) + (u.pn & 1) * 256;
#pragma unroll
            for (int ai = 0; ai < 2; ++ai)
#pragma unroll
                for (int m = 0; m < 4; ++m) { const int row = row0 + ai * 128 + m * 16; const float rs = rsh[row]; float ss = 0.f;
#pragma unroll
                    for (int bj = 0; bj < 2; ++bj) { *(u32x4*)(base + (size_t)row * 512 + bj * 128 + cl0) = pack8s(acc[ai][bj][m][0], acc[ai][bj][m][1], rs); ss += sumsq8(acc[ai][bj][m][0], acc[ai][bj][m][1], rs); }
                    ss += __shfl_xor(ss, 16); ss += __shfl_xor(ss, 32);
                    if (fq == 0) SSQ[(size_t)row * 16 + (u.pn >> 1) * 8 + (u.pn & 1) * 4 + wc] = ss; }
        } else if (wc < 2) {
#pragma unroll
            for (int ai = 0; ai < 2; ++ai)
#pragma unroll
                for (int m = 0; m < 4; ++m) { const int row = row0 + ai * 128 + m * 16; const float rs = rsh[row];
                    f32x4 a = acc[ai][0][m][0] * rs, b = acc[ai][0][m][1] * rs; rope8(a, b, ctab, stab, row, cl0 >> 1);
                    *(u32x4*)(KR + (size_t)row * 64 + cl0) = pack8s(a, b, 1.f); }
        }
    }
};
struct EpiMlaUp {
    static constexpr bool PERM = true;
    bf16_t* Q; bf16_t* KN; bf16_t* V; const float* SSQ; const float* ctab; const float* stab;
    __device__ __forceinline__ void operator()(const f32x4 (&acc)[2][2][4][2], const pg8::Unit& u, int wr, int wc, int fr, int fq) const {
        EPI_ROWS_BEGIN();
#pragma unroll
        for (int ai = 0; ai < 2; ++ai)
#pragma unroll
            for (int m = 0; m < 4; ++m) { const int row = row0 + ai * 128 + m * 16;
                const f32x4 s0 = *(const f32x4*)(SSQ + (size_t)row * 16 + u.gi * 8), s1 = *(const f32x4*)(SSQ + (size_t)row * 16 + u.gi * 8 + 4);
                const float ss = ((s0[0] + s0[1]) + (s0[2] + s0[3])) + ((s1[0] + s1[1]) + (s1[2] + s1[3]));
                const float rs = rsqrtf(ss * (1.0f / 512.0f) + EPS);
                if (u.gi == 0) {
#pragma unroll
                    for (int bj = 0; bj < 2; ++bj) { const int col = u.pn * 256 + bj * 128 + cl0; const int w = col % DQK;
                        f32x4 a = acc[ai][bj][m][0] * rs, b = acc[ai][bj][m][1] * rs;
                        if (w >= 128) rope8(a, b, ctab, stab, row, (w - 128) >> 1);
                        *(u32x4*)(Q + (size_t)row * NQUP + col) = pack8s(a, b, 1.f); }
                } else {
                    *(u32x4*)(KN + (size_t)row * D + u.pn * 128 + cl0) = pack8s(acc[ai][0][m][0], acc[ai][0][m][1], rs);
                    *(u32x4*)(V + (size_t)row * D + u.pn * 128 + cl0) = pack8s(acc[ai][1][m][0], acc[ai][1][m][1], rs);
                } }
    }
};
struct EpiMix {
    static constexpr bool PERM = true;
    bf16_t* MIX; float* SSM;
    __device__ __forceinline__ void operator()(const f32x4 (&acc)[2][2][4][2], const pg8::Unit& u, int wr, int wc, int fr, int fq) const {
        EPI_ROWS_BEGIN();
#pragma unroll
        for (int ai = 0; ai < 2; ++ai)
#pragma unroll
            for (int m = 0; m < 4; ++m) { const int row = row0 + ai * 128 + m * 16; float ss = 0.f;
#pragma unroll
                for (int bj = 0; bj < 2; ++bj) { *(u32x4*)(MIX + (size_t)row * D + u.pn * 256 + bj * 128 + cl0) = pack8s(acc[ai][bj][m][0], acc[ai][bj][m][1], 1.f); ss += sumsq8(acc[ai][bj][m][0], acc[ai][bj][m][1], 1.f); }
                ss += __shfl_xor(ss, 16); ss += __shfl_xor(ss, 32);
                if (fq == 0) SSM[(size_t)row * 32 + u.pn * 4 + wc] = ss; }
    }
};
__device__ __forceinline__ float gelu_tanh(float x) {
    const float y = 0.7978845608028654f * (x + 0.044715f * x * x * x);
    const float e = __builtin_amdgcn_exp2f(y * 2.8853900817779268f);
    const float t = 1.0f - 2.0f * __builtin_amdgcn_rcpf(1.0f + e);
    return 0.5f * x * (1.0f + t);
}
__device__ __forceinline__ float dpp_prev1(float prev, float cur) {
    const int y = __builtin_amdgcn_update_dpp(0, __float_as_int(prev), 0x121, 0xf, 0xf, false);
    return __int_as_float(__builtin_amdgcn_update_dpp(y, __float_as_int(cur), 0x111, 0xf, 0xf, false));
}
__device__ __forceinline__ float dpp_prev2(float prev, float cur) {
    const int y = __builtin_amdgcn_update_dpp(0, __float_as_int(prev), 0x122, 0xf, 0xf, false);
    return __int_as_float(__builtin_amdgcn_update_dpp(y, __float_as_int(cur), 0x112, 0xf, 0xf, false));
}
struct EpiFfnUpConv {
    static constexpr bool PERM = true;
    bf16_t* ACT; const float* rsh; const float* cw; const float* cb; LAS unsigned char* xch;
    __device__ __forceinline__ void operator()(f32x4 (&acc)[2][2][4][2], const pg8::Unit& u, int wr, int wc, int fr, int fq) const {
        const int cl0 = wc * 32 + 8 * fq; const int lr0 = 128 * wr + fr, grow0 = 254 * u.pm - 2 + lr0;
#pragma unroll
        for (int g = 0; g < 8; ++g) { const int grow = grow0 + 16 * g; const bool ok = (unsigned)grow < (unsigned)S; const float rs = ok ? rsh[ok ? grow : 0] : 0.f;
#pragma unroll
            for (int bj = 0; bj < 2; ++bj)
#pragma unroll
                for (int n = 0; n < 2; ++n)
#pragma unroll
                    for (int e = 0; e < 4; ++e) acc[g >> 2][bj][g & 3][n][e] = ok ? acc[g >> 2][bj][g & 3][n][e] * rs : 0.f; }
        LAS f32x4* X = (LAS f32x4*)xch + wc * 32;
        if (wr == 0 && fr >= 14) { LAS f32x4* d = X + ((fr - 14) * 4 + fq) * 4; d[0] = acc[1][0][3][0]; d[1] = acc[1][0][3][1]; d[2] = acc[1][1][3][0]; d[3] = acc[1][1][3][1]; }
        asm volatile("s_waitcnt lgkmcnt(0)" ::: "memory"); __builtin_amdgcn_s_barrier(); asm volatile("" ::: "memory");
        f32x4 hg[2], hu[2]; hg[0] = hg[1] = hu[0] = hu[1] = (f32x4){0.f, 0.f, 0.f, 0.f};
        if (wr == 1 && fr >= 14) { const LAS f32x4* d = X + ((fr - 14) * 4 + fq) * 4; hg[0] = d[0]; hg[1] = d[1]; hu[0] = d[2]; hu[1] = d[3]; }
        const int c0 = u.pn * 128 + cl0;
#pragma unroll
        for (int n = 0; n < 2; ++n) { const float* wg = cw + c0 + 4 * n; const float* wu = cw + FF + c0 + 4 * n;
            const f32x4 w0g = *(const f32x4*)(wg), w1g = *(const f32x4*)(wg + FF2), w2g = *(const f32x4*)(wg + 2 * FF2), bg = *(const f32x4*)(cb + c0 + 4 * n);
            const f32x4 w0u = *(const f32x4*)(wu), w1u = *(const f32x4*)(wu + FF2), w2u = *(const f32x4*)(wu + 2 * FF2), bu = *(const f32x4*)(cb + FF + c0 + 4 * n);
            f32x4 pg = hg[n], pu = hu[n];
#pragma unroll
            for (int g = 0; g < 8; ++g) { const f32x4 cg = acc[g >> 2][0][g & 3][n], cu = acc[g >> 2][1][g & 3][n]; f32x4 o;
#pragma unroll
                for (int e = 0; e < 4; ++e) {
                    const float gt = w2g[e] * cg[e] + w1g[e] * dpp_prev1(pg[e], cg[e]) + w0g[e] * dpp_prev2(pg[e], cg[e]) + bg[e];
                    const float up = w2u[e] * cu[e] + w1u[e] * dpp_prev1(pu[e], cu[e]) + w0u[e] * dpp_prev2(pu[e], cu[e]) + bu[e];
                    o[e] = gelu_tanh(gt) * up; }
                acc[g >> 2][0][g & 3][n] = o; pg = cg; pu = cu; asm volatile("" : "+v"(acc[g >> 2][0][g & 3][n])); SBAR(); } }
#pragma unroll
        for (int g = 0; g < 8; ++g) { const int lr = lr0 + 16 * g, grow = grow0 + 16 * g;
            if (lr >= 2 && grow < S) *(u32x4*)(ACT + (size_t)grow * FF + c0) = pack8s(acc[g >> 2][0][g & 3][0], acc[g >> 2][0][g & 3][1], 1.f); }
    }
};
struct EpiMobaKvq {
    static constexpr bool PERM = true;
    unsigned char* wsb; float* KMEAN; const float* rsh; int pn_off;
    __device__ __forceinline__ void operator()(const f32x4 (&acc)[2][2][4][2], const pg8::Unit& u, int wr, int wc, int fr, int fq) const {
        EPI_ROWS_BEGIN();
        const int pe = u.pn + pn_off;
        bf16_t* base = (bf16_t*)(wsb + (pe < 16 ? WS_KB + (size_t)(pe >> 3) * (WS_VB - WS_KB) : WS_Q)); const int ct = (pe & 7) * 256;
        f32x4 cs00 = (f32x4){0.f, 0.f, 0.f, 0.f}, cs01 = cs00, cs10 = cs00, cs11 = cs00;
#pragma unroll
        for (int ai = 0; ai < 2; ++ai)
#pragma unroll
            for (int m = 0; m < 4; ++m) { const int row = row0 + ai * 128 + m * 16; const float rs = rsh[row];
#pragma unroll
                for (int bj = 0; bj < 2; ++bj) *(u32x4*)(base + (size_t)row * D + ct + bj * 128 + cl0) = pack8s(acc[ai][bj][m][0], acc[ai][bj][m][1], rs);
                cs00 += acc[ai][0][m][0] * rs; cs01 += acc[ai][0][m][1] * rs; cs10 += acc[ai][1][m][0] * rs; cs11 += acc[ai][1][m][1] * rs; }
        if (pe < 8) {
#define KM_ADD(CS, bj, n) do { _Pragma("unroll") for (int e = 0; e < 4; ++e) { float v = CS[e]; v += __shfl_xor(v, 1); v += __shfl_xor(v, 2); v += __shfl_xor(v, 4); v += __shfl_xor(v, 8); \
                if (fr == 0) (void)__hip_atomic_fetch_add(KMEAN + (size_t)u.pm * D + ct + (bj) * 128 + cl0 + (n) * 4 + e, v, __ATOMIC_RELAXED, __HIP_MEMORY_SCOPE_AGENT); } } while (0)
            KM_ADD(cs00, 0, 0); KM_ADD(cs01, 0, 1); KM_ADD(cs10, 1, 0); KM_ADD(cs11, 1, 1);
#undef KM_ADD
        }
    }
};

namespace att {
constexpr int V_OFF = 0, KN_OFF = 16384, KR_OFF = 32768, BUF_BYTES = 40960;
constexpr int WS_OFF = 2 * BUF_BYTES, BT_OFF = WS_OFF + 8 * 64 * 4, ATT_LDS = BT_OFF + 512;
#define KSWZ(row, colB) ((row) * 256 + ((colB) ^ (((row) & 7) << 4)))
#define RSWZ(row, colB) ((row) * 128 + ((colB) ^ (((row) & 7) << 4)))
__device__ __forceinline__ int v_st(int k, int c) { const int kk = (k & ~0xC) | ((k & 4) << 1) | ((k & 8) >> 1); return ((kk >> 3) * 4 + (c >> 5)) * 512 + ((kk & 7) * 32 + (c & 31)) * 2; }
__device__ __forceinline__ int v_rd_base(int lane) { return ((lane & 3) << 3) | (((lane >> 2) & 3) << 6) | (((lane >> 4) & 1) << 5) | (((lane >> 5) & 1) << 8); }
constexpr int v_rd_off(int d0, int ks, int half) { return d0 * 512 + ks * 4096 + half * 2048; }
__device__ __forceinline__ int crow(int r, int hi) { return (r & 3) + 8 * (r >> 2) + 4 * hi; }

struct Args { const bf16_t* Q; const bf16_t* K; const bf16_t* KR; const bf16_t* V; bf16_t* O; const unsigned* SEL; const float* relb; const int* pos; };

template <int BUF>
__device__ __forceinline__ void pv_tile(f32x16* o, int vb0, bf16x8 pa0, bf16x8 pa1, bf16x8 pa2, bf16x8 pa3) {
#define TRRD(dst, off) asm volatile("ds_read_b64_tr_b16 %0, %1 offset:%2" : "=&v"(dst) : "v"(vb0), "i"(off) : "memory")
#define PV_D0(d0) do { s16x4 l0, l1, l2, l3, h0, h1, h2, h3; constexpr int b_ = BUF * BUF_BYTES + V_OFF + v_rd_off(d0, 0, 0); \
        TRRD(l0, b_); TRRD(h0, b_ + 2048); TRRD(l1, b_ + 4096); TRRD(h1, b_ + 6144); TRRD(l2, b_ + 8192); TRRD(h2, b_ + 10240); TRRD(l3, b_ + 12288); TRRD(h3, b_ + 14336); \
        asm volatile("s_waitcnt lgkmcnt(0)" ::: "memory"); SBAR(); \
        o[d0] = __builtin_amdgcn_mfma_f32_32x32x16_bf16(pa0, (bf16x8){l0[0], l0[1], l0[2], l0[3], h0[0], h0[1], h0[2], h0[3]}, o[d0], 0, 0, 0); \
        o[d0] = __builtin_amdgcn_mfma_f32_32x32x16_bf16(pa1, (bf16x8){l1[0], l1[1], l1[2], l1[3], h1[0], h1[1], h1[2], h1[3]}, o[d0], 0, 0, 0); \
        o[d0] = __builtin_amdgcn_mfma_f32_32x32x16_bf16(pa2, (bf16x8){l2[0], l2[1], l2[2], l2[3], h2[0], h2[1], h2[2], h2[3]}, o[d0], 0, 0, 0); \
        o[d0] = __builtin_amdgcn_mfma_f32_32x32x16_bf16(pa3, (bf16x8){l3[0], l3[1], l3[2], l3[3], h3[0], h3[1], h3[2], h3[3]}, o[d0], 0, 0, 0); } while (0)
    PV_D0(0); PV_D0(1); PV_D0(2); PV_D0(3);
#undef PV_D0
#undef TRRD
}

template <bool MOBA>
__device__ __forceinline__ void attn_unit(LAS unsigned char* lds, const Args& T, int h, int qb) {
    constexpr int NDQ = MOBA ? 8 : 12, QPITCH = MOBA ? 2048 : 3072, HD = MOBA ? 128 : 192;
    constexpr float SCALE = MOBA ? 0.08838834764831845f : 0.07216878364870323f;
    constexpr float C2 = 1.4426950408889634f * SCALE, THR = 8.f;
    const int tid = opaque_tid(), wid = __builtin_amdgcn_readfirstlane(tid >> 6), lane = tid & 63, r32 = lane & 31, hi = lane >> 5;
    const int q0 = qb * 256, qlo = q0 + wid * 32, qrow = qlo + r32, NT = 4 * (qb + 1), own = qb;
    LAS float* wsf = (LAS float*)(lds + WS_OFF) + wid * 64; LAS float* li_l = wsf; LAS float* al_l = wsf + 32;
    LAS float* btab = (LAS float*)(lds + BT_OFF);
    bf16x8 qr[NDQ];
    { const bf16_t* Qp = T.Q + (size_t)qrow * QPITCH + h * HD + hi * 8;
#pragma unroll
      for (int d0 = 0; d0 < NDQ; ++d0) qr[d0] = *(const bf16x8*)(Qp + d0 * 16); }
    unsigned selm = 0u; int pq = 0;
    if (MOBA) { selm = T.SEL[(size_t)qrow * NH + h]; pq = T.pos[qrow];
        if (tid < 128) { int n = tid, b = n;
            if (n >= 16) { b = 16 + (int)(logf((float)n * (1.0f / 16.0f)) / 2.0794415416798357f * 16.0f); b = b > 31 ? 31 : b; }
            btab[tid] = (T.relb[b * NH + h] - T.relb[31 * NH + h]) * (1.0f / SCALE); } }
    unsigned vk[2], vv[2], vr = 0u;
#pragma unroll
    for (int i = 0; i < 2; ++i) { const int pb = (wid + 8 * i) * 1024 + lane * 16;
        { const int row = pb >> 8, ch = ((pb & 255) >> 4) ^ (row & 7); vk[i] = (unsigned)(row * (D * 2) + ch * 16); }
        { const int sub = pb >> 9, w = (pb & 511) >> 1, kk = (sub >> 2) * 8 + (w >> 5), c = (sub & 3) * 32 + (w & 31);
          const int k = (kk & ~0xC) | ((kk & 4) << 1) | ((kk & 8) >> 1); vv[i] = (unsigned)(k * (D * 2) + c * 2); } }
    if (!MOBA) { const int pb = wid * 1024 + lane * 16, row = pb >> 7, ch = ((pb & 127) >> 4) ^ (row & 7); vr = (unsigned)(row * 128 + ch * 16); }
    const char* Kg = (const char*)(T.K + h * 128); const char* Vg = (const char*)(T.V + h * 128); const char* Rg = (const char*)T.KR;
#define GLDS(g, l) __builtin_amdgcn_global_load_lds((const unsigned*)(g), (LAS unsigned*)(l), 16, 0, 0)
#define DMA_TILE(kb, bf) do { const char* kt_ = Kg + (size_t)(kb) * (D * 2); const char* vt_ = Vg + (size_t)(kb) * (D * 2); \
        GLDS(kt_ + vk[0], lds + (bf) * BUF_BYTES + KN_OFF + wid * 1024); GLDS(kt_ + vk[1], lds + (bf) * BUF_BYTES + KN_OFF + (wid + 8) * 1024); \
        GLDS(vt_ + vv[0], lds + (bf) * BUF_BYTES + V_OFF + wid * 1024); GLDS(vt_ + vv[1], lds + (bf) * BUF_BYTES + V_OFF + (wid + 8) * 1024); \
        if (!MOBA) GLDS(Rg + (size_t)(kb) * 128 + vr, lds + (bf) * BUF_BYTES + KR_OFF + wid * 1024); } while (0)
    const int vb0 = (int)(unsigned)(uintptr_t)(lds) + v_rd_base(lane);
    int kna[4], kra[4];
#pragma unroll
    for (int dd = 0; dd < 4; ++dd) { kna[dd] = KN_OFF + KSWZ(r32, (dd * 16 + hi * 8) * 2); kra[dd] = KR_OFF + RSWZ(r32, (dd * 16 + hi * 8) * 2); }
    float m_reg = -1e30f, l_reg = 0.f; f32x16 o[4];
#pragma unroll
    for (int d = 0; d < 4; ++d) o[d] = f32x16{};
    DMA_TILE(0, 0); VM_WAIT(); __syncthreads();

#define ATT_STEP(t, BUF) do { const int kb = (t) * 64; \
        if ((t) + 1 < NT) DMA_TILE(kb + 64, (BUF) ^ 1); \
        bool keep = true; const int blk = (t) >> 2; \
        if (MOBA && blk < own) keep = ((selm >> blk) & 1u) != 0u; \
        if (!MOBA || __any(keep)) { \
            f32x16 p0 = f32x16{}, p1 = f32x16{}; \
            _Pragma("unroll") for (int d0 = 0; d0 < 8; ++d0) { const LAS unsigned char* a = lds + (BUF) * BUF_BYTES + kna[d0 & 3] + (d0 >> 2) * 128; \
                const bf16x8 b0 = *(const LAS bf16x8*)a, b1 = *(const LAS bf16x8*)(a + 32 * 256); \
                p0 = __builtin_amdgcn_mfma_f32_32x32x16_bf16(b0, qr[d0], p0, 0, 0, 0); p1 = __builtin_amdgcn_mfma_f32_32x32x16_bf16(b1, qr[d0], p1, 0, 0, 0); } \
            if (!MOBA) { _Pragma("unroll") for (int d0 = 0; d0 < 4; ++d0) { const LAS unsigned char* a = lds + (BUF) * BUF_BYTES + kra[d0]; \
                const bf16x8 b0 = *(const LAS bf16x8*)a, b1 = *(const LAS bf16x8*)(a + 32 * 128); \
                p0 = __builtin_amdgcn_mfma_f32_32x32x16_bf16(b0, qr[(NDQ - 4) + d0], p0, 0, 0, 0); p1 = __builtin_amdgcn_mfma_f32_32x32x16_bf16(b1, qr[(NDQ - 4) + d0], p1, 0, 0, 0); } } \
            const float NEGINF = -__builtin_inff(); \
            if (MOBA) { \
                if (!keep) { _Pragma("unroll") for (int r = 0; r < 16; ++r) { p0[r] = NEGINF; p1[r] = NEGINF; } } \
                if (T.pos[qlo] - T.pos[kb + 63] < 128) {     \
                    _Pragma("unroll") for (int g = 0; g < 4; ++g) { const i32x4 pk0 = *(const i32x4*)(T.pos + kb + 8 * g + 4 * hi), pk1 = *(const i32x4*)(T.pos + kb + 32 + 8 * g + 4 * hi); \
                        _Pragma("unroll") for (int e = 0; e < 4; ++e) { const int d0_ = pq - pk0[e], d1_ = pq - pk1[e]; \
                            if ((unsigned)d0_ < 128u) p0[4 * g + e] += btab[d0_]; if ((unsigned)d1_ < 128u) p1[4 * g + e] += btab[d1_]; } } } \
            } \
            if (kb + 63 > qlo) { _Pragma("unroll") for (int r = 0; r < 16; ++r) { const int c = kb + crow(r, hi); if (c > qrow) p0[r] = NEGINF; if (c + 32 > qrow) p1[r] = NEGINF; } } \
            float pmax = p0[0]; _Pragma("unroll") for (int r = 1; r < 16; ++r) pmax = fmaxf(pmax, p0[r]); _Pragma("unroll") for (int r = 0; r < 16; ++r) pmax = fmaxf(pmax, p1[r]); \
            { auto rr_ = __builtin_amdgcn_permlane32_swap(__float_as_uint(pmax), __float_as_uint(pmax), false, false); pmax = fmaxf(__uint_as_float(rr_[0]), __uint_as_float(rr_[1])); } \
            float mn, alpha; \
            if (__all((pmax - m_reg) * SCALE <= THR)) { mn = m_reg; alpha = 1.f; } \
            else { mn = fmaxf(m_reg, pmax); alpha = __builtin_amdgcn_exp2f((m_reg - mn) * C2); m_reg = mn; } \
            const float mnL = -mn * C2; \
            _Pragma("unroll") for (int r = 0; r < 16; ++r) { p0[r] = __builtin_amdgcn_exp2f(fmaf(p0[r], C2, mnL)); p1[r] = __builtin_amdgcn_exp2f(fmaf(p1[r], C2, mnL)); } \
            float ps = 0.f; _Pragma("unroll") for (int r = 0; r < 16; ++r) ps += p0[r]; _Pragma("unroll") for (int r = 0; r < 16; ++r) ps += p1[r]; \
            { auto rr_ = __builtin_amdgcn_permlane32_swap(__float_as_uint(ps), __float_as_uint(ps), false, false); ps = __uint_as_float(rr_[0]) + __uint_as_float(rr_[1]); } \
            l_reg = l_reg * alpha + ps; \
            bf16x8 pa0, pa1, pa2, pa3; \
            PK4(p0, 0, pa0); PK4(p0, 8, pa1); PK4(p1, 0, pa2); PK4(p1, 8, pa3); \
            if (__any(alpha < 1.f)) { if (hi == 0) al_l[r32] = alpha; LDS_WAIT(); \
                _Pragma("unroll") for (int d_ = 0; d_ < 4; ++d_) _Pragma("unroll") for (int r = 0; r < 16; ++r) o[d_][r] *= al_l[crow(r, hi)]; } \
            SBAR(); pv_tile<BUF>(o, vb0, pa0, pa1, pa2, pa3); \
        } \
        VM_WAIT(); __syncthreads(); } while (0)
#define PK4(P, B_, OUT) do { unsigned a0_ = cvt_pk_bf16(P[B_ + 0], P[B_ + 1]), a1_ = cvt_pk_bf16(P[B_ + 2], P[B_ + 3]); \
        unsigned b0_ = cvt_pk_bf16(P[B_ + 4], P[B_ + 5]), b1_ = cvt_pk_bf16(P[B_ + 6], P[B_ + 7]); \
        auto r0_ = __builtin_amdgcn_permlane32_swap(a0_, b0_, false, false); auto r1_ = __builtin_amdgcn_permlane32_swap(a1_, b1_, false, false); \
        u32x4 w_ = {r0_[0], r1_[0], r0_[1], r1_[1]}; OUT = __builtin_bit_cast(bf16x8, w_); } while (0)

    for (int t = 0; t < NT; t += 2) { ATT_STEP(t, 0); ATT_STEP(t + 1, 1); }
#undef PK4
#undef ATT_STEP
#undef DMA_TILE
#undef GLDS
    if (hi == 0) li_l[r32] = l_reg; LDS_WAIT();
    bf16_t* Ow = T.O + (size_t)qlo * D + h * 128;
#pragma unroll
    for (int r = 0; r < 16; ++r) { const int orow = crow(r, hi); const float rl = __builtin_amdgcn_rcpf(li_l[orow]);
#pragma unroll
        for (int d0 = 0; d0 < 4; ++d0) { const float v = o[d0][r] * rl; const float vn = __shfl_xor(v, 1);
            if ((r32 & 1) == 0) *(unsigned*)(Ow + (size_t)orow * D + d0 * 32 + r32) = cvt_pk_bf16(v, vn); } }
    __syncthreads();
}
}

#define XB_TMO      128
#define XB_XCNT(j)  (256  + 64 * (j))
#define XB_XSUB(j)  (1280 + 64 * (j))
#define XB_XGEN(j)  (2304 + 64 * (j))
#define XB_TOP      3328
#define XB_TOPGEN   3392
#define XCD_BAR_WORDS 3456
#define XB_SPIN_CAP (1u << 18)
__device__ __forceinline__ unsigned xb_ld(unsigned* p)              { return __hip_atomic_load(p, __ATOMIC_RELAXED, __HIP_MEMORY_SCOPE_AGENT); }
__device__ __forceinline__ unsigned xb_add(unsigned* p, unsigned v) { return __hip_atomic_fetch_add(p, v, __ATOMIC_RELAXED, __HIP_MEMORY_SCOPE_AGENT); }
__device__ __forceinline__ unsigned xb_xcc_id() { return (unsigned)__builtin_amdgcn_s_getreg((3 << 11) | 20) & 0xFu; }
#define XB_SPIN(cond, bar) do { unsigned _sp = 0; while (cond) { __builtin_amdgcn_s_sleep(1); \
    if ((++_sp & 255u) == 0u) { if (xb_ld(&(bar)[XB_TMO])) break; if (_sp > XB_SPIN_CAP) { atomicAdd(&(bar)[XB_TMO], 1u); break; } } } } while (0)
struct XcdBarrier { unsigned* bar; unsigned x; volatile LAS unsigned* st; };
__device__ __forceinline__ XcdBarrier xcd_barrier_post(unsigned* bar, volatile LAS unsigned* st) {
    XcdBarrier b; b.bar = bar; b.x = xb_xcc_id(); b.st = st;
    if (threadIdx.x == 0) (void)xb_add(&bar[XB_XCNT(b.x)], 1u);
    return b;
}
__device__ __forceinline__ void xcd_barrier_complete(unsigned* bar, unsigned x, unsigned& nloc, unsigned& nx) {
    const unsigned G = gridDim.x * gridDim.y * gridDim.z;
    unsigned sum, cnt, mine, sp = 0u;
    for (;;) {
        sum = 0u; cnt = 0u; mine = 0u;
#pragma unroll
        for (unsigned j = 0; j < 16; ++j) { const unsigned c = xb_ld(&bar[XB_XCNT(j)]); sum += c; cnt += (c > 0u) ? 1u : 0u; mine = (j == x) ? c : mine; }
        if (sum == G) break;
        __builtin_amdgcn_s_sleep(1);
        if ((++sp & 255u) == 0u) { if (xb_ld(&bar[XB_TMO])) break; if (sp > XB_SPIN_CAP) { atomicAdd(&bar[XB_TMO], 1u); break; } }
    }
    nloc = mine > 0u ? mine : 1u; nx = cnt > 0u ? cnt : 1u;
}
__device__ __forceinline__ void xcd_barrier(const XcdBarrier& b) {
    asm volatile("s_waitcnt vmcnt(0)" ::: "memory");
    __syncthreads();
    if (threadIdx.x == 0) {
        unsigned* bar = b.bar;
        __builtin_amdgcn_s_waitcnt(0);
        unsigned nloc = b.st[0], nx = b.st[1];
        if (nloc == 0u) { xcd_barrier_complete(bar, b.x, nloc, nx); b.st[0] = nloc; b.st[1] = nx; }
        const unsigned old = xb_add(&bar[XB_XSUB(b.x)], 1u);
        const unsigned gen = old / nloc;
        if (old + 1u == (gen + 1u) * nloc) {
            __builtin_amdgcn_fence(__ATOMIC_RELEASE, "agent");
            asm volatile("s_waitcnt vmcnt(0)" ::: "memory");
            const unsigned og = xb_add(&bar[XB_TOP], 1u);
            const unsigned tg = og / nx;
            if (og + 1u == (tg + 1u) * nx) xb_add(&bar[XB_TOPGEN], 1u);
            else XB_SPIN(xb_ld(&bar[XB_TOPGEN]) == tg, bar);
            __builtin_amdgcn_fence(__ATOMIC_ACQUIRE, "agent");
            xb_add(&bar[XB_XGEN(b.x)], 1u);
            asm volatile("s_waitcnt vmcnt(0)" ::: "memory");
        } else {
            XB_SPIN(xb_ld(&bar[XB_XGEN(b.x)]) == gen, bar);
            __builtin_amdgcn_fence(__ATOMIC_ACQUIRE, "agent");
            asm volatile("s_waitcnt vmcnt(0)" ::: "memory");
        }
    }
    __syncthreads();
}

struct Params {
    const float* x; const int* pos; const float* gains; const float* a_w_in; const float* a_q_norm; const float* a_w_q_up; const float* a_kv_norm; const float* a_w_kv_up;
    const float* a_w_o; const float* b_kv_norm; const float* b_w_kv; const float* b_w_q; const float* b_w_o; const float* rel_bias; const float* ffn_w_in; const float* ffn_conv_w;
    const float* ffn_conv_b; const float* ffn_w_out; float* out; unsigned char* ws; int ph_lo, ph_hi;
};

struct WDesc { const float* src; const float* gain; bf16_t* dst; int K, Nsrc, Ndst, map; };
__device__ __forceinline__ int colmap(int map, int n) {
    if (map == 1) { if (n < 1024) return n; if (n >= NIN) return -1; const int j = n - 1024; return 1024 + (j >> 1) + (j & 1) * 32; }
    if (map == 2) { const int hh = n / DQK, w = n % DQK; if (w < 128) return n; const int j = w - 128; return hh * DQK + 128 + (j >> 1) + (j & 1) * 32; }
    if (map == 3) { const int t = n >> 8, j = n & 255; return j < 128 ? t * 128 + j : FF + t * 128 + (j - 128); }
    return n;
}
__device__ __forceinline__ WDesc wdesc(const Params& p, int i) {
    WDesc w; bf16_t* ws = (bf16_t*)p.ws; w.gain = nullptr; w.map = 0;
    if (i < 2) { w.src = p.a_w_in + (size_t)i * D * NIN; w.gain = p.gains + (size_t)(i * 4 + 0) * D; w.dst = (bf16_t*)(p.ws + WS_WIN) + (size_t)i * NINP * D; w.K = D; w.Nsrc = NIN; w.Ndst = NINP; w.map = 1; }
    else if (i < 4) { const int l = i - 2; w.src = p.a_w_q_up + (size_t)l * QL * NQUP; w.gain = p.a_q_norm + l * QL; w.dst = (bf16_t*)(p.ws + WS_WUPG) + (size_t)l * 7168 * 512; w.K = QL; w.Nsrc = NQUP; w.Ndst = NQUP; w.map = 2; }
    else if (i < 6) { const int l = i - 4; w.src = p.a_w_kv_up + (size_t)l * KVL * NKVUP; w.gain = p.a_kv_norm + l * KVL; w.dst = (bf16_t*)(p.ws + WS_WUPG) + (size_t)l * 7168 * 512 + (size_t)NQUP * 512; w.K = KVL; w.Nsrc = NKVUP; w.Ndst = NKVUP; }
    else if (i < 10) { const int l = i - 6; w.src = (l < 2 ? p.a_w_o + (size_t)l * D * D : p.b_w_o + (size_t)(l - 2) * D * D); w.dst = (bf16_t*)(p.ws + WS_WO) + (size_t)l * D * D; w.K = D; w.Nsrc = D; w.Ndst = D; }
    else if (i == 10) { w.src = p.b_w_kv; w.gain = p.b_kv_norm; w.dst = (bf16_t*)(p.ws + WS_WKVQ); w.K = D; w.Nsrc = 4096; w.Ndst = 4096; }
    else if (i == 11) { w.src = p.b_w_q; w.gain = p.gains + (size_t)(2 * 4 + 0) * D; w.dst = (bf16_t*)(p.ws + WS_WKVQ) + (size_t)4096 * D; w.K = D; w.Nsrc = D; w.Ndst = D; }
    else if (i == 12) { w.src = p.b_w_q + (size_t)D * D; w.gain = p.gains + (size_t)(3 * 4 + 0) * D; w.dst = (bf16_t*)(p.ws + WS_WQ1); w.K = D; w.Nsrc = D; w.Ndst = D; }
    else if (i < 17) { const int l = i - 13; w.src = p.ffn_w_in + (size_t)l * D * FF2; w.gain = p.gains + (size_t)(l * 4 + 2) * D; w.dst = (bf16_t*)(p.ws + WS_WUP) + (size_t)l * FF2 * D; w.K = D; w.Nsrc = FF2; w.Ndst = FF2; w.map = 3; }
    else { const int l = i - 17; w.src = p.ffn_w_out + (size_t)l * FF * D; w.dst = (bf16_t*)(p.ws + WS_WDN) + (size_t)l * D * FF; w.K = FF; w.Nsrc = D; w.Ndst = D; }
    (void)ws; return w;
}
constexpr int NWDESC = 21;
__device__ __forceinline__ void transpose_item(const WDesc& w, LAS float* scr, int item, int lane) {
    const int nblk = w.Ndst / 64, kb = item / nblk, nb = item % nblk, k0 = 64 * kb, n0 = 64 * nb;
    const int nl = (lane & 15) * 4, kr = lane >> 4;
    const int s0 = colmap(w.map, n0 + nl), s1 = colmap(w.map, n0 + nl + 1), s2 = colmap(w.map, n0 + nl + 2), s3 = colmap(w.map, n0 + nl + 3);
    const bool vec = (s0 >= 0) && (s1 == s0 + 1) && (s2 == s0 + 2) && (s3 == s0 + 3);
    f32x4 v[16];
    if (vec) {
#pragma unroll
        for (int i = 0; i < 16; ++i) v[i] = *(const f32x4*)(w.src + (size_t)(k0 + 4 * i + kr) * w.Nsrc + s0);
    } else {
#pragma unroll
        for (int i = 0; i < 16; ++i) { const float* r = w.src + (size_t)(k0 + 4 * i + kr) * w.Nsrc;
            v[i] = (f32x4){s0 >= 0 ? r[s0] : 0.f, s1 >= 0 ? r[s1] : 0.f, s2 >= 0 ? r[s2] : 0.f, s3 >= 0 ? r[s3] : 0.f}; }
    }
    if (w.gain) {
#pragma unroll
        for (int i = 0; i < 16; ++i) v[i] = v[i] * w.gain[k0 + 4 * i + kr];
    }
#pragma unroll
    for (int i = 0; i < 16; ++i) { LAS float* d = scr + (4 * i + kr) * 65 + nl; d[0] = v[i][0]; d[1] = v[i][1]; d[2] = v[i][2]; d[3] = v[i][3]; }
    LDS_WAIT(); asm volatile("" ::: "memory");
    const int c = lane & 7;
#pragma unroll
    for (int j = 0; j < 8; ++j) { const int n = (lane >> 3) + 8 * j; const LAS float* sp = scr + (8 * c) * 65 + n;
        u32x4 o; o.x = cvt_pk_bf16(sp[0 * 65], sp[1 * 65]); o.y = cvt_pk_bf16(sp[2 * 65], sp[3 * 65]); o.z = cvt_pk_bf16(sp[4 * 65], sp[5 * 65]); o.w = cvt_pk_bf16(sp[6 * 65], sp[7 * 65]);
        *(u32x4*)(w.dst + (size_t)(n0 + n) * w.K + k0 + 8 * c) = o; }
    LDS_WAIT(); asm volatile("" ::: "memory");
}
__device__ __forceinline__ void prologue_phase(const Params& p, LAS unsigned char* lds, int vcu, int G, int wave, int lane) {
    LAS float* scr = (LAS float*)(lds + wave * 16640);
    const int gw = vcu * NWAVES + wave, NGW = G * NWAVES;
    int start = gw;
    for (int d = 0; d < NWDESC; ++d) { const WDesc w = wdesc(p, d); const int n = (w.K / 64) * (w.Ndst / 64);
        int it = start; for (; it < n; it += NGW) transpose_item(w, scr, it, lane);
        start = it - n; }
    bf16_t* HB = (bf16_t*)(p.ws + WS_HB); float* RSH = (float*)(p.ws + WS_RSH);
    for (int row = gw; row < S; row += NGW) { const float* xr = p.x + (size_t)row * D; float ss = 0.f;
#pragma unroll
        for (int j = 0; j < 4; ++j) { const f32x4 a = *(const f32x4*)(xr + j * 512 + lane * 8), b = *(const f32x4*)(xr + j * 512 + lane * 8 + 4);
            ss += sumsq8(a, b, 1.f); *(u32x4*)(HB + (size_t)row * D + j * 512 + lane * 8) = pack8s(a, b, 1.f); }
        ss = wave_sum(ss); if (lane == 0) RSH[row] = rsqrtf(ss * (1.0f / D) + EPS); }
    { float* RC = (float*)(p.ws + WS_RCOS); float* RS = (float*)(p.ws + WS_RSIN);
      for (int i = gw * 64 + lane; i < S * 32; i += NGW * 64) { const int row = i >> 5, k = i & 31;
          const float inv = exp2f(-(float)k * (13.287712379549449f / 32.0f)); const float ang = (float)p.pos[row] * inv;
          const float kq = rintf(ang * 0.15915494309189535f); float r = fmaf(-kq, 6.28125f, ang); r = fmaf(-kq, 1.9353071795864769e-3f, r);
          const float rev = r * 0.15915494309189535f; RC[i] = __builtin_amdgcn_cosf(rev); RS[i] = __builtin_amdgcn_sinf(rev); } }
    float* KM = (float*)(p.ws + WS_KMEAN);
    for (int i = gw * 64 + lane; i < 32 * D; i += NGW * 64) KM[i] = 0.f;
}

__device__ __forceinline__ void resid_phase(const Params& p, const float* hin, const float* gain, int vcu, int G, int wave, int lane) {
    const int gw = vcu * NWAVES + wave, NGW = G * NWAVES;
    const bf16_t* MIX = (const bf16_t*)(p.ws + WS_MIX); const float* SSM = (const float*)(p.ws + WS_SSM);
    bf16_t* HB = (bf16_t*)(p.ws + WS_HB); float* RSH = (float*)(p.ws + WS_RSH);
    for (int row = gw; row < S; row += NGW) {
        float sv = (lane < 32) ? SSM[(size_t)row * 32 + lane] : 0.f; sv = wave_sum(sv);
        const float rs = rsqrtf(sv * (1.0f / D) + EPS); float ss = 0.f;
#pragma unroll
        for (int j = 0; j < 4; ++j) { const int col = j * 512 + lane * 8;
            const u32x4 mw = *(const u32x4*)(MIX + (size_t)row * D + col);
            const f32x4 h0 = *(const f32x4*)(hin + (size_t)row * D + col), h1 = *(const f32x4*)(hin + (size_t)row * D + col + 4);
            const f32x4 g0 = *(const f32x4*)(gain + col), g1 = *(const f32x4*)(gain + col + 4);
            f32x4 a, b;
            a[0] = h0[0] + bflo(mw.x) * rs * g0[0]; a[1] = h0[1] + bfhi(mw.x) * rs * g0[1]; a[2] = h0[2] + bflo(mw.y) * rs * g0[2]; a[3] = h0[3] + bfhi(mw.y) * rs * g0[3];
            b[0] = h1[0] + bflo(mw.z) * rs * g1[0]; b[1] = h1[1] + bfhi(mw.z) * rs * g1[1]; b[2] = h1[2] + bflo(mw.w) * rs * g1[2]; b[3] = h1[3] + bfhi(mw.w) * rs * g1[3];
            *(f32x4*)(p.out + (size_t)row * D + col) = a; *(f32x4*)(p.out + (size_t)row * D + col + 4) = b;
            *(u32x4*)(HB + (size_t)row * D + col) = pack8s(a, b, 1.f); ss += sumsq8(a, b, 1.f); }
        ss = wave_sum(ss); if (lane == 0) RSH[row] = rsqrtf(ss * (1.0f / D) + EPS); }
}
__device__ __forceinline__ void gate_phase(const Params& p, LAS unsigned char* lds, int vcu, int G, int tid) {
    const bf16_t* Q = (const bf16_t*)(p.ws + WS_Q); const float* KM = (const float*)(p.ws + WS_KMEAN); unsigned* SEL = (unsigned*)(p.ws + WS_SEL);
    LAS float* km = (LAS float*)lds;
    for (int unit = vcu; unit < NH * 16; unit += G) {
        const int h = unit >> 4, qc = unit & 15;
        __syncthreads();
        for (int i = tid; i < 32 * 128; i += 512) km[i] = KM[(size_t)(i >> 7) * D + h * 128 + (i & 127)] * (1.0f / 256.0f);
        __syncthreads();
        const int q = qc * 512 + tid, own = q >> 8;
        float acc[32];
#pragma unroll
        for (int g = 0; g < 4; ++g) { float a8[8];
#pragma unroll
            for (int j = 0; j < 8; ++j) a8[j] = 0.f;
#pragma unroll 1
            for (int d = 0; d < 128; d += 8) { const u32x4 qw = *(const u32x4*)(Q + (size_t)q * D + h * 128 + d);
                const float q0 = bflo(qw.x), q1 = bfhi(qw.x), q2 = bflo(qw.y), q3 = bfhi(qw.y), q4 = bflo(qw.z), q5 = bfhi(qw.z), q6 = bflo(qw.w), q7 = bfhi(qw.w);
#pragma unroll
                for (int j = 0; j < 8; ++j) { const f32x4 k0 = *(const LAS f32x4*)(km + (g * 8 + j) * 128 + d), k1 = *(const LAS f32x4*)(km + (g * 8 + j) * 128 + d + 4);
                    a8[j] += (q0 * k0[0] + q1 * k0[1]) + (q2 * k0[2] + q3 * k0[3]) + (q4 * k1[0] + q5 * k1[1]) + (q6 * k1[2] + q7 * k1[3]); } }
#pragma unroll
            for (int j = 0; j < 8; ++j) acc[g * 8 + j] = a8[j]; }
        unsigned mask = 0u; const int cnt = own < 3 ? own : 3;
#pragma unroll
        for (int k = 0; k < 3; ++k) { if (k < cnt) { float best = -__builtin_inff(); int bi = 0;
#pragma unroll
                for (int n = 0; n < 32; ++n) { const bool ok = (n < own) && !((mask >> n) & 1u) && (acc[n] > best); if (ok) { best = acc[n]; bi = n; } }
                mask |= 1u << bi; } }
        SEL[(size_t)q * NH + h] = mask | (1u << own);
    }
}

__global__ void __launch_bounds__(NWAVES * 64, 2) fwd_kernel(Params p) {
    extern __shared__ __attribute__((aligned(16))) unsigned char lds_raw[];
    LAS unsigned char* lds = (LAS unsigned char*)lds_raw;
    const int tid = threadIdx.x, lane = tid & 63, wave = __builtin_amdgcn_readfirstlane(tid >> 6);
    const int G = gridDim.x; const int bx = blockIdx.x; const int vcu = (G % 8 == 0) ? (bx % 8) * (G / 8) + bx / 8 : bx;
    volatile LAS unsigned* MISC = (volatile LAS unsigned*)(lds + MISC_OFF);
    for (int u = tid; u < (LDS_BYTES - LDSCTL_OFF) / 4; u += NWAVES * 64) ((LAS unsigned*)(lds + LDSCTL_OFF))[u] = 0u;
    __syncthreads();
    unsigned* ctl = (unsigned*)(p.ws + WS_CTL);
    XcdBarrier bar; bar.bar = ctl + CW_BAR; bar.x = 0; bar.st = nullptr;
    const bool one_launch = (p.ph_hi - p.ph_lo) > 1;
    if (one_launch) bar = xcd_barrier_post(ctl + CW_BAR, MISC + 8);
    const int lo = p.ph_lo, hi = p.ph_hi;
    int ph = 0;
#define IN() (lo <= ph && ph < hi)
#define SEAM() do { if (ph + 1 < hi) xcd_barrier(bar); } while (0)

    bf16_t* HB = (bf16_t*)(p.ws + WS_HB); float* RSH = (float*)(p.ws + WS_RSH);
    bf16_t* CQ = (bf16_t*)(p.ws + WS_CQ); bf16_t* CKV = (bf16_t*)(p.ws + WS_CKV); bf16_t* KROPE = (bf16_t*)(p.ws + WS_KROPE); float* SSQ = (float*)(p.ws + WS_SSQ);
    bf16_t* Qb = (bf16_t*)(p.ws + WS_Q); bf16_t* KN = (bf16_t*)(p.ws + WS_KN); bf16_t* Vb = (bf16_t*)(p.ws + WS_V);
    bf16_t* KB = (bf16_t*)(p.ws + WS_KB); bf16_t* VB = (bf16_t*)(p.ws + WS_VB); float* KMEAN = (float*)(p.ws + WS_KMEAN);
    bf16_t* Ob = (bf16_t*)(p.ws + WS_O); bf16_t* MIX = (bf16_t*)(p.ws + WS_MIX); float* SSM = (float*)(p.ws + WS_SSM);
    bf16_t* Ub = (bf16_t*)(p.ws + WS_U); bf16_t* ACT = (bf16_t*)(p.ws + WS_ACT);
    const float* RCOS = (const float*)(p.ws + WS_RCOS); const float* RSIN = (const float*)(p.ws + WS_RSIN);

    if (SITE(0) && IN()) { REPS(0) { { const int t_ = opaque_tid(); prologue_phase(p, lds, vcu, G, __builtin_amdgcn_readfirstlane(t_ >> 6), t_ & 63); } } SEAM(); } ++ph;

    for (int layer = 0; layer < NLAYER; ++layer) {
        if (layer < 2) {
            if (SITE(1) && IN()) { REPS(1) { pg8::Sched Sc; Sc.init(S, D, HB, (const bf16_t*)(p.ws + WS_WIN) + (size_t)layer * NINP * D, NINP, nullptr, nullptr, 0, G, bx);
                EpiMlaIn E{CQ, CKV, KROPE, SSQ, RSH, RCOS, RSIN};
                pg8::gemm_phase<EpiMlaIn, true, true>(lds, D, Sc, E); } SEAM(); } ++ph;
            if (SITE(2) && IN()) { REPS(2) { const bf16_t* W = (const bf16_t*)(p.ws + WS_WUPG) + (size_t)layer * 7168 * 512;
                pg8::Sched Sc; Sc.init(S, 512, CQ, W, NQUP, CKV, W + (size_t)NQUP * 512, NKVUP, G, bx);
                EpiMlaUp E{Qb, KN, Vb, SSQ, RCOS, RSIN};
                pg8::gemm_phase<EpiMlaUp, true, true>(lds, 512, Sc, E); } SEAM(); } ++ph;
            if (SITE(3) && IN()) { REPS(3) { att::Args T{Qb, KN, KROPE, Vb, Ob, nullptr, nullptr, p.pos};
                for (int it = vcu; it < NH * 16; it += G) { const int h = it >> 4, y = it & 15;
                    att::attn_unit<false>(lds, T, h, y); att::attn_unit<false>(lds, T, h, 31 - y); }
                } SEAM(); } ++ph;
        } else {
            if (SITE(4) && IN()) { REPS(4) { const bool first = (layer == 2);
                pg8::Sched Sc; Sc.init(S, D, HB, first ? (const bf16_t*)(p.ws + WS_WKVQ) : (const bf16_t*)(p.ws + WS_WQ1), first ? 6144 : 2048, nullptr, nullptr, 0, G, bx);
                EpiMobaKvq E{p.ws, KMEAN, RSH, first ? 0 : 16};
                pg8::gemm_phase<EpiMobaKvq, true, true>(lds, D, Sc, E); } SEAM(); } ++ph;
            if (SITE(5) && IN()) { REPS(5) { gate_phase(p, lds, vcu, G, opaque_tid()); } SEAM(); } ++ph;
            if (SITE(6) && IN()) { REPS(6) { att::Args T{Qb, KB, nullptr, VB, Ob, (const unsigned*)(p.ws + WS_SEL), p.rel_bias, p.pos};
                for (int it = vcu; it < NH * 16; it += G) { const int h = it >> 4, y = it & 15;
                    att::attn_unit<true>(lds, T, h, y); att::attn_unit<true>(lds, T, h, 31 - y); }
                } SEAM(); } ++ph;
        }
        if (SITE(7) && IN()) { REPS(7) { pg8::Sched Sc; Sc.init(S, D, Ob, (const bf16_t*)(p.ws + WS_WO) + (size_t)layer * D * D, D, nullptr, nullptr, 0, G, bx);
            EpiMix E{MIX, SSM};
            pg8::gemm_phase<EpiMix, false, true>(lds, D, Sc, E); } SEAM(); } ++ph;
        if (SITE(8) && IN()) { REPS(8) { { const int t_ = opaque_tid(); resid_phase(p, layer == 0 ? p.x : p.out, p.gains + (size_t)(layer * 4 + 1) * D, vcu, G, __builtin_amdgcn_readfirstlane(t_ >> 6), t_ & 63); } } SEAM(); } ++ph;
        if (SITE(9) && IN()) { REPS(9) { pg8::Sched Sc; Sc.init(S, D, HB, (const bf16_t*)(p.ws + WS_WUP) + (size_t)layer * FF2 * D, FF2, nullptr, nullptr, 0, G, bx, 254, -2);
            EpiFfnUpConv E{ACT, RSH, p.ffn_conv_w + (size_t)layer * 3 * FF2, p.ffn_conv_b + (size_t)layer * FF2, lds + RING_BYTES};
            pg8::gemm_phase<EpiFfnUpConv, true, true, true>(lds, D, Sc, E); } SEAM(); } ++ph;
        if (SITE(11) && IN()) { REPS(11) { pg8::Sched Sc; Sc.init(S, FF, ACT, (const bf16_t*)(p.ws + WS_WDN) + (size_t)layer * D * FF, D, nullptr, nullptr, 0, G, bx);
            EpiMix E{MIX, SSM};
            pg8::gemm_phase<EpiMix, false, true>(lds, FF, Sc, E); } SEAM(); } ++ph;
        if (SITE(12) && IN()) { REPS(12) { { const int t_ = opaque_tid(); resid_phase(p, p.out, p.gains + (size_t)(layer * 4 + 3) * D, vcu, G, __builtin_amdgcn_readfirstlane(t_ >> 6), t_ & 63); } } SEAM(); } ++ph;
    }
#undef IN
#undef SEAM
}

extern "C" void kernel_launch(void* const* d_in, const int* in_sizes, int n_in, void* d_out, int out_size, void* d_ws, size_t ws_size, hipStream_t stream) {
    static int grid = 0;
    if (grid == 0) {
        if (n_in != 18 || in_sizes[0] != S * D || out_size != S * D || ws_size < WS_END) { fprintf(stderr, "kernel_launch: unexpected shapes (n_in %d, in0 %d, out %d, ws %zu)\n", n_in, n_in > 0 ? in_sizes[0] : -1, out_size, ws_size); grid = -1; return; }
        int dev = 0, cus = 0, per_cu = 0;
        if (hipGetDevice(&dev) != hipSuccess || hipDeviceGetAttribute(&cus, hipDeviceAttributeMultiprocessorCount, dev) != hipSuccess) { grid = -1; return; }
        if (hipFuncSetAttribute((const void*)fwd_kernel, hipFuncAttributeMaxDynamicSharedMemorySize, LDS_BYTES) != hipSuccess) { fprintf(stderr, "kernel_launch: hipFuncSetAttribute failed\n"); grid = -1; return; }
        if (hipOccupancyMaxActiveBlocksPerMultiprocessor(&per_cu, (const void*)fwd_kernel, NWAVES * 64, LDS_BYTES) != hipSuccess || per_cu < 1) fprintf(stderr, "kernel_launch: occupancy query reports %d\n", per_cu);
        (void)hipGetLastError();
        grid = cus;
    }
    if (grid < 0) return;
    (void)hipMemsetAsync((char*)d_ws + WS_CTL, 0, CTL_ZERO_BYTES, stream);
    Params p{};
    p.x = (const float*)d_in[0]; p.pos = (const int*)d_in[1]; p.gains = (const float*)d_in[2]; p.a_w_in = (const float*)d_in[3]; p.a_q_norm = (const float*)d_in[4];
    p.a_w_q_up = (const float*)d_in[5]; p.a_kv_norm = (const float*)d_in[6]; p.a_w_kv_up = (const float*)d_in[7]; p.a_w_o = (const float*)d_in[8]; p.b_kv_norm = (const float*)d_in[9];
    p.b_w_kv = (const float*)d_in[10]; p.b_w_q = (const float*)d_in[11]; p.b_w_o = (const float*)d_in[12]; p.rel_bias = (const float*)d_in[13]; p.ffn_w_in = (const float*)d_in[14];
    p.ffn_conv_w = (const float*)d_in[15]; p.ffn_conv_b = (const float*)d_in[16]; p.ffn_w_out = (const float*)d_in[17]; p.out = (float*)d_out; p.ws = (unsigned char*)d_ws;
#if MK_ONE_LAUNCH
    p.ph_lo = 0; p.ph_hi = NPHASE;
    hipLaunchKernelGGL(fwd_kernel, dim3(grid), dim3(NWAVES * 64), LDS_BYTES, stream, p);
#else
    for (int ph = 0; ph < NPHASE; ++ph) { p.ph_lo = ph; p.ph_hi = ph + 1;
        hipLaunchKernelGGL(fwd_kernel, dim3(grid), dim3(NWAVES * 64), LDS_BYTES, stream, p); }
#endif
}
```

```cpp
#include <hip/hip_runtime.h>
#include <cstdio>
#include <cstdint>

#ifndef MK_ONE_LAUNCH
#define MK_ONE_LAUNCH 1
#endif

#ifndef SITE_MASK
#define SITE_MASK 0xFFFF
#endif
#define SITE(n) (((SITE_MASK) >> (n)) & 1)
#ifndef REP_SITE
#define REP_SITE -1
#endif
#ifndef REP_N
#define REP_N 1
#endif
#define REPS(n) for (int rep_ = 0; rep_ < ((n) == (REP_SITE) ? (REP_N) : 1); ++rep_)
#define LAS __attribute__((address_space(3)))
#define GAS __attribute__((address_space(1)))
typedef unsigned short bf16_t;
typedef short bf16x8 __attribute__((ext_vector_type(8)));
typedef short s16x4 __attribute__((ext_vector_type(4)));
typedef float f32x2 __attribute__((ext_vector_type(2)));
typedef float f32x4 __attribute__((ext_vector_type(4)));
typedef float f32x16 __attribute__((ext_vector_type(16)));
typedef unsigned u32x2 __attribute__((ext_vector_type(2)));
typedef unsigned u32x4 __attribute__((ext_vector_type(4)));
typedef int i32x4 __attribute__((ext_vector_type(4)));
typedef GAS unsigned gu32;

constexpr int S = 8192, D = 2048, NH = 16, FF = 5632, FF2 = 11264;
constexpr int QL = 512, KVL = 512, DQK = 192;
constexpr int NIN = 1088, NINP = 1280;
constexpr int NQUP = NH * DQK, NKVUP = NH * 256;
constexpr int NLAYER = 4;
constexpr float EPS = 1e-6f;
constexpr int NPHASE = 1 + 2 * 8 + 2 * 9;

constexpr size_t MiB = 1u << 20;
constexpr size_t WS_CTL = 0, CTL_ZERO_BYTES = 1 * MiB;
constexpr size_t WS_WIN = 2 * MiB;
constexpr size_t WS_WUPG = 12 * MiB;
constexpr size_t WS_WO = 26 * MiB;
constexpr size_t WS_WKVQ = 58 * MiB;
constexpr size_t WS_WQ1 = 82 * MiB;
constexpr size_t WS_WUP = 90 * MiB;
constexpr size_t WS_WDN = 266 * MiB;
constexpr size_t WS_HB = 354 * MiB;
constexpr size_t WS_RSH = 386 * MiB;
constexpr size_t WS_CQ = 387 * MiB;
constexpr size_t WS_CKV = 395 * MiB;
constexpr size_t WS_KROPE = 403 * MiB;
constexpr size_t WS_SSQ = 404 * MiB;
constexpr size_t WS_Q = 405 * MiB;
constexpr size_t WS_KN = 453 * MiB;
constexpr size_t WS_V = 485 * MiB;
constexpr size_t WS_KB = 517 * MiB;
constexpr size_t WS_VB = 549 * MiB;
constexpr size_t WS_KMEAN = 581 * MiB;
constexpr size_t WS_SEL = 582 * MiB;
constexpr size_t WS_O = 583 * MiB;
constexpr size_t WS_MIX = 615 * MiB;
constexpr size_t WS_SSM = 647 * MiB;
constexpr size_t WS_U = 648 * MiB;
constexpr size_t WS_ACT = 824 * MiB;
constexpr size_t WS_RCOS = 912 * MiB;
constexpr size_t WS_RSIN = 913 * MiB;
constexpr size_t WS_END = 914 * MiB;

constexpr size_t WS_LIST = 648 * MiB;
constexpr size_t WS_OP = 664 * MiB;
constexpr size_t WS_MLP = 792 * MiB;
constexpr int CW_CNT = 8192;
constexpr int CW_BAR = 4096;

constexpr int RING_BYTES = 131072;
constexpr int LDSCTL_OFF = 139264, MISC_OFF = LDSCTL_OFF + 320;
constexpr int LDS_BYTES = 147456;
constexpr int NWAVES = 8;

#define LDS_WAIT() asm volatile("s_waitcnt lgkmcnt(0)" ::: "memory")
#define VM_WAIT() asm volatile("s_waitcnt vmcnt(0)" ::: "memory")
#define SBAR() __builtin_amdgcn_sched_barrier(0)

__device__ __forceinline__ int opaque_tid() { int t = threadIdx.x; asm volatile("" : "+v"(t)); return t; }
__device__ __forceinline__ unsigned cvt_pk_bf16(float lo, float hi) { unsigned r; asm volatile("v_cvt_pk_bf16_f32 %0, %1, %2" : "=v"(r) : "v"(lo), "v"(hi)); return r; }
__device__ __forceinline__ float bf2f(unsigned short b) { return __uint_as_float(((unsigned)b) << 16); }
__device__ __forceinline__ float bflo(unsigned w) { return __uint_as_float(w << 16); }
__device__ __forceinline__ float bfhi(unsigned w) { return __uint_as_float(w & 0xffff0000u); }
__device__ __forceinline__ float wave_sum(float v) {
#pragma unroll
    for (int o = 1; o < 64; o <<= 1) v += __shfl_xor(v, o);
    return v;
}

namespace pg8 {
constexpr int BM = 256, BK = 64, HALF = 128, HTB = HALF * BK * 2, STAGE_BYTES = 8 * HTB, NXCD = 8, WGM = 8;
__host__ __device__ __forceinline__ int lds_byte(int r, int c) { const int st = (r >> 4) * 2 + (c >> 5), rr = r & 15, cc = c & 31, ob = rr * 64 + cc * 2; return st * 1024 + (ob ^ (((ob >> 9) & 1) << 5)); }
__host__ __device__ __forceinline__ void stage_rc(int b, int& R, int& C) { const int st = b / 1024, sb = b % 1024, swz = sb ^ (((sb >> 9) & 1) << 5); R = (st >> 1) * 16 + swz / 64; C = (st & 1) * 32 + (swz % 64) / 2; }
__host__ __device__ __forceinline__ int perm32(int rho) { const int n = rho >> 4, i = rho & 15; return 8 * (i >> 2) + 4 * n + (i & 3); }

struct Unit { int pm, pn, gi; };

struct Sched {
    int nM, nN0, nwg0, nN1, nwg1, G, c;
    const char* A0; const char* B0; const char* A1; const char* B1; size_t tstep; long astep, aoff;
    __device__ __forceinline__ void init(int M, int K, const bf16_t* a0, const bf16_t* b0, int N0, const bf16_t* a1, const bf16_t* b1, int N1, int G_, int c_, int mstep = BM, int moff = 0) {
        nM = (M - moff + mstep - 1) / mstep; nN0 = N0 / BM; nwg0 = nM * nN0; nN1 = N1 / BM; nwg1 = nM * nN1; G = G_; c = c_;
        A0 = (const char*)a0; B0 = (const char*)b0; A1 = (const char*)a1; B1 = (const char*)b1; tstep = (size_t)BM * K * 2; astep = (long)mstep * K * 2; aoff = (long)moff * K * 2;
    }
    __device__ __forceinline__ void map(int wgid, int nwg, int nN, Unit& u) const {
        { const int q = nwg / NXCD, r = nwg % NXCD, xcd = wgid % NXCD, off = wgid / NXCD; wgid = (xcd < r ? xcd * (q + 1) : r * (q + 1) + (xcd - r) * q) + off; }
        const int nig = WGM * nN, gid = wgid / nig, fm = gid * WGM, gsz = (nM - fm) < WGM ? (nM - fm) : WGM;
        u.pm = fm + ((wgid % nig) % gsz); u.pn = (wgid % nig) / gsz;
    }
    __device__ __forceinline__ bool next(int i, Unit& u) const {
        const long L = (long)i * G + c;
        if (L < nwg0) { u.gi = 0; map((int)L, nwg0, nN0, u); return true; }
        if (L < nwg0 + nwg1) { u.gi = 1; map((int)(L - nwg0), nwg1, nN1, u); return true; }
        return false;
    }
    __device__ __forceinline__ const char* aptr(const Unit& u) const { return (u.gi ? A1 : A0) + ((long)u.pm * astep + aoff); }
    __device__ __forceinline__ const char* bptr(const Unit& u) const { return (u.gi ? B1 : B0) + (size_t)u.pn * tstep; }
};

template <class Epi, bool ALIGN_EPI, bool SP2, bool APERM = false>
__device__ __forceinline__ void gemm_phase(LAS unsigned char* lds, const int K, const Sched& S, const Epi& E) {
    const int tid = opaque_tid(), wid = __builtin_amdgcn_readfirstlane(tid >> 6), lane = tid & 63, wr = wid >> 2, wc = wid & 3, fr = lane & 15, fq = lane >> 4;
    const int nt = K / BK;
    unsigned voffA[2], voffB[2];
#pragma unroll
    for (int i = 0; i < 2; ++i) { int R, C; stage_rc(tid * 16 + i * 8192, R, C); const int Rb = Epi::PERM ? ((R & ~31) + perm32(R & 31)) : R;
        const int Ra = APERM ? (128 * (R >> 6) + (R & 63)) : R;
        voffA[i] = (unsigned)(Ra * K + C) * 2u; voffB[i] = (unsigned)(Rb * K + C) * 2u; }
    const size_t kstep = (size_t)(BK * 2);
    const size_t hstep = (size_t)HALF * K * 2, hstepA = APERM ? (size_t)64 * K * 2 : hstep;
    const unsigned ldsw = (unsigned)wid * 1024u;
    const int aoff = lds_byte(wr * 64 + fr, fq * 8), boff = lds_byte(wc * 32 + fr, fq * 8);
#define PG8_SA(b, h) (((b) * 2 + (h)) * HTB)
#define PG8_SB(b, h) ((4 + (b) * 2 + (h)) * HTB)
#define PG8_STAGE(bufoff, gbase, voff) do { _Pragma("unroll") for (int _i = 0; _i < 2; ++_i) \
        __builtin_amdgcn_global_load_lds((const unsigned*)((const char*)(gbase) + (voff)[_i]), (LAS unsigned*)(lds + (bufoff) + ldsw + _i * 8192), 16, 0, 0); } while (0)
#define PG8_LDA(dst, b, h) do { _Pragma("unroll") for (int m = 0; m < 4; ++m) _Pragma("unroll") for (int k = 0; k < 2; ++k) dst[m][k] = *(const LAS bf16x8*)(lds + PG8_SA(b, h) + aoff + m * 2048 + k * 1024); } while (0)
#define PG8_LDB(dst, b, h) do { _Pragma("unroll") for (int n = 0; n < 2; ++n) _Pragma("unroll") for (int k = 0; k < 2; ++k) dst[n][k] = *(const LAS bf16x8*)(lds + PG8_SB(b, h) + boff + n * 2048 + k * 1024); } while (0)
#define PG8_MMA(ai, bj, At, Bt) do { __builtin_amdgcn_s_setprio(1); _Pragma("unroll") for (int m = 0; m < 4; ++m) _Pragma("unroll") for (int n = 0; n < 2; ++n) _Pragma("unroll") for (int k = 0; k < 2; ++k) \
        acc[ai][bj][m][n] = __builtin_amdgcn_mfma_f32_16x16x32_bf16(Bt[n][k], At[m][k], acc[ai][bj][m][n], 0, 0, 0); __builtin_amdgcn_s_setprio(0); } while (0)
#define PG8_WAIT_V(n) asm volatile("s_waitcnt vmcnt(" #n ")" ::: "memory")
#define PG8_WAIT_L(n) asm volatile("s_waitcnt lgkmcnt(" #n ")" ::: "memory")
#define PG8_BAR __builtin_amdgcn_s_barrier()
#define PG8_SCHED __builtin_amdgcn_sched_barrier(0)
    Unit cur, nxt; int ui = 0;
    if (!S.next(0, cur)) return;
    f32x4 acc[2][2][4][2];
#pragma unroll
    for (int a = 0; a < 2; ++a)
#pragma unroll
        for (int b = 0; b < 2; ++b)
#pragma unroll
            for (int m = 0; m < 4; ++m)
#pragma unroll
                for (int n = 0; n < 2; ++n) acc[a][b][m][n] = (f32x4){0.f, 0.f, 0.f, 0.f};
    bf16x8 At[4][2], B0[2][2], B1[2][2];
    const char* cA = S.aptr(cur); const char* cB = S.bptr(cur);
    if constexpr (SP2) {
        PG8_STAGE(PG8_SB(0, 0), cB, voffB); PG8_STAGE(PG8_SB(0, 1), cB + hstep, voffB); PG8_STAGE(PG8_SA(0, 0), cA, voffA); PG8_STAGE(PG8_SA(0, 1), cA + hstepA, voffA);
        if (wr == 1) PG8_BAR;
        PG8_WAIT_V(2); PG8_BAR;
        PG8_STAGE(PG8_SB(1, 0), cB + kstep, voffB); PG8_STAGE(PG8_SA(1, 0), cA + kstep, voffA); PG8_STAGE(PG8_SB(1, 1), cB + hstep + kstep, voffB);
        PG8_WAIT_V(6); PG8_BAR;
    } else {
        PG8_STAGE(PG8_SB(0, 0), cB, voffB); PG8_STAGE(PG8_SA(0, 0), cA, voffA); PG8_STAGE(PG8_SB(0, 1), cB + hstep, voffB); PG8_STAGE(PG8_SA(0, 1), cA + hstepA, voffA);
        if (wr == 1) PG8_BAR;
        PG8_WAIT_V(4); PG8_BAR;
        PG8_STAGE(PG8_SB(1, 0), cB + kstep, voffB); PG8_STAGE(PG8_SA(1, 0), cA + kstep, voffA); PG8_STAGE(PG8_SB(1, 1), cB + hstep + kstep, voffB);
        PG8_WAIT_V(6); PG8_BAR;
    }
    for (;;) {
        const bool has_next = S.next(ui + 1, nxt);
        const char* nA = has_next ? S.aptr(nxt) : cA; const char* nB = has_next ? S.bptr(nxt) : cB;
        for (int t = 0; t < nt; t += 2) {
            const bool last = (t == nt - 2);
            const char* a1 = cA + (size_t)(t + 1) * kstep;
            const char* a2 = last ? nA : cA + (size_t)(t + 2) * kstep; const char* b2 = last ? nB : cB + (size_t)(t + 2) * kstep;
            const char* a3 = a2 + kstep; const char* b3 = b2 + kstep;
            if constexpr (SP2) {
            PG8_LDB(B0, 0, 0); PG8_LDB(B1, 0, 1); PG8_SCHED; PG8_LDA(At, 0, 0); PG8_STAGE(PG8_SA(1, 1), a1 + hstepA, voffA);
            PG8_WAIT_V(8); PG8_WAIT_L(0); PG8_BAR; PG8_MMA(0, 0, At, B0); PG8_MMA(0, 1, At, B1); PG8_BAR; PG8_SCHED;
            PG8_LDA(At, 0, 1); PG8_STAGE(PG8_SB(0, 0), b2, voffB); PG8_STAGE(PG8_SB(0, 1), b2 + hstep, voffB); PG8_STAGE(PG8_SA(0, 0), a2, voffA);
            PG8_WAIT_V(8); PG8_WAIT_L(0); PG8_BAR; PG8_MMA(1, 0, At, B0); PG8_MMA(1, 1, At, B1); PG8_BAR; PG8_SCHED;
            PG8_LDB(B0, 1, 0); PG8_LDB(B1, 1, 1); PG8_SCHED; PG8_LDA(At, 1, 0); PG8_STAGE(PG8_SA(0, 1), a2 + hstepA, voffA);
            PG8_WAIT_V(8); PG8_WAIT_L(0); PG8_BAR; PG8_MMA(0, 0, At, B0); PG8_MMA(0, 1, At, B1); PG8_BAR; PG8_SCHED;
            PG8_LDA(At, 1, 1); PG8_STAGE(PG8_SB(1, 0), b3, voffB); PG8_STAGE(PG8_SB(1, 1), b3 + hstep, voffB); PG8_STAGE(PG8_SA(1, 0), a3, voffA);
            PG8_WAIT_V(8); PG8_WAIT_L(0); PG8_BAR; PG8_MMA(1, 0, At, B0); PG8_MMA(1, 1, At, B1); PG8_BAR; PG8_SCHED;
            } else {
            PG8_LDB(B0, 0, 0); PG8_SCHED; PG8_LDA(At, 0, 0); PG8_STAGE(PG8_SA(1, 1), a1 + hstepA, voffA);
            PG8_WAIT_L(8); PG8_BAR; PG8_WAIT_L(0); PG8_MMA(0, 0, At, B0); PG8_BAR; PG8_SCHED;
            PG8_LDB(B1, 0, 1); PG8_STAGE(PG8_SB(0, 0), b2, voffB);
            PG8_BAR; PG8_WAIT_L(0); PG8_MMA(0, 1, At, B1); PG8_BAR;
            PG8_LDA(At, 0, 1); PG8_STAGE(PG8_SA(0, 0), a2, voffA);
            PG8_BAR; PG8_WAIT_L(0); PG8_MMA(1, 0, At, B0); PG8_BAR; PG8_SCHED;
            PG8_STAGE(PG8_SB(0, 1), b2 + hstep, voffB);
            PG8_WAIT_V(6); PG8_BAR; PG8_MMA(1, 1, At, B1); PG8_BAR;
            PG8_LDB(B0, 1, 0); PG8_SCHED; PG8_LDA(At, 1, 0); PG8_STAGE(PG8_SA(0, 1), a2 + hstepA, voffA);
            PG8_WAIT_L(8); PG8_BAR; PG8_WAIT_L(0); PG8_MMA(0, 0, At, B0); PG8_BAR; PG8_SCHED;
            PG8_LDB(B1, 1, 1); PG8_STAGE(PG8_SB(1, 0), b3, voffB);
            PG8_BAR; PG8_WAIT_L(0); PG8_MMA(0, 1, At, B1); PG8_BAR;
            PG8_LDA(At, 1, 1); PG8_STAGE(PG8_SA(1, 0), a3, voffA);
            PG8_BAR; PG8_WAIT_L(0); PG8_MMA(1, 0, At, B0); PG8_BAR; PG8_SCHED;
            PG8_STAGE(PG8_SB(1, 1), b3 + hstep, voffB);
            PG8_WAIT_V(6); PG8_BAR; PG8_MMA(1, 1, At, B1); PG8_BAR;
            }
        }
        if constexpr (ALIGN_EPI) { if (wr == 0) PG8_BAR; }
        E(acc, cur, wr, wc, fr, fq);
        if (!has_next) break;
#pragma unroll
        for (int a = 0; a < 2; ++a)
#pragma unroll
            for (int b = 0; b < 2; ++b)
#pragma unroll
                for (int m = 0; m < 4; ++m)
#pragma unroll
                    for (int n = 0; n < 2; ++n) acc[a][b][m][n] = (f32x4){0.f, 0.f, 0.f, 0.f};
        cur = nxt; cA = nA; cB = nB; ++ui;
        if constexpr (ALIGN_EPI) { if (wr == 1) PG8_BAR; }
    }
    PG8_WAIT_V(0);
    if constexpr (!ALIGN_EPI) { if (wr == 0) PG8_BAR; }
    PG8_BAR;
#undef PG8_SA
#undef PG8_SB
#undef PG8_STAGE
#undef PG8_LDA
#undef PG8_LDB
#undef PG8_MMA
#undef PG8_WAIT_V
#undef PG8_WAIT_L
#undef PG8_BAR
#undef PG8_SCHED
}
}

#define EPI_ROWS_BEGIN() const int row0 = u.pm * 256 + wr * 64 + fr; const int cl0 = wc * 32 + 8 * fq;
__device__ __forceinline__ u32x4 pack8s(f32x4 a, f32x4 b, float s) {
    u32x4 w; w.x = cvt_pk_bf16(a[0] * s, a[1] * s); w.y = cvt_pk_bf16(a[2] * s, a[3] * s); w.z = cvt_pk_bf16(b[0] * s, b[1] * s); w.w = cvt_pk_bf16(b[2] * s, b[3] * s); return w;
}
__device__ __forceinline__ float sumsq8(f32x4 a, f32x4 b, float s) {
    a = a * s; b = b * s; return (a[0] * a[0] + a[1] * a[1]) + (a[2] * a[2] + a[3] * a[3]) + (b[0] * b[0] + b[1] * b[1]) + (b[2] * b[2] + b[3] * b[3]);
}
__device__ __forceinline__ void rope8(f32x4& a, f32x4& b, const float* ctab, const float* stab, int row, int i0) {
    const f32x4 cs = *(const f32x4*)(ctab + (size_t)row * 32 + i0), sn = *(const f32x4*)(stab + (size_t)row * 32 + i0);
    const f32x4 a2 = (f32x4){a[0] * cs[0] - a[1] * sn[0], a[0] * sn[0] + a[1] * cs[0], a[2] * cs[1] - a[3] * sn[1], a[2] * sn[1] + a[3] * cs[1]};
    const f32x4 b2 = (f32x4){b[0] * cs[2] - b[1] * sn[2], b[0] * sn[2] + b[1] * cs[2], b[2] * cs[3] - b[3] * sn[3], b[2] * sn[3] + b[3] * cs[3]};
    a = a2; b = b2;
}

struct EpiMlaIn {
    static constexpr bool PERM = true;
    bf16_t* CQ; bf16_t* CKV; bf16_t* KR; float* SSQ; const float* rsh; const float* ctab; const float* stab;
    __device__ __forceinline__ void operator()(const f32x4 (&acc)[2][2][4][2], const pg8::Unit& u, int wr, int wc, int fr, int fq) const {
        EPI_ROWS_BEGIN();
        if (u.pn < 4) {
            bf16_t* base = (u.pn < 2 ? CQ : CKV) + (u.pn & 1) * 256;
#pragma unroll
            for (int ai = 0; ai < 2; ++ai)
#pragma unroll
                for (int m = 0; m < 4; ++m) { const int row = row0 + ai * 128 + m * 16; const float rs = rsh[row]; float ss = 0.f;
#pragma unroll
                    for (int bj = 0; bj < 2; ++bj) { *(u32x4*)(base + (size_t)row * 512 + bj * 128 + cl0) = pack8s(acc[ai][bj][m][0], acc[ai][bj][m][1], rs); ss += sumsq8(acc[ai][bj][m][0], acc[ai][bj][m][1], rs); }
                    ss += __shfl_xor(ss, 16); ss += __shfl_xor(ss, 32);
                    if (fq == 0) SSQ[(size_t)row * 16 + (u.pn >> 1) * 8 + (u.pn & 1) * 4 + wc] = ss; }
        } else if (wc < 2) {
#pragma unroll
            for (int ai = 0; ai < 2; ++ai)
#pragma unroll
                for (int m = 0; m < 4; ++m) { const int row = row0 + ai * 128 + m * 16; const float rs = rsh[row];
                    f32x4 a = acc[ai][0][m][0] * rs, b = acc[ai][0][m][1] * rs; rope8(a, b, ctab, stab, row, cl0 >> 1);
                    *(u32x4*)(KR + (size_t)row * 64 + cl0) = pack8s(a, b, 1.f); }
        }
    }
};
struct EpiMlaUp {
    static constexpr bool PERM = true;
    bf16_t* Q; bf16_t* KN; bf16_t* V; const float* SSQ; const float* ctab; const float* stab;
    __device__ __forceinline__ void operator()(const f32x4 (&acc)[2][2][4][2], const pg8::Unit& u, int wr, int wc, int fr, int fq) const {
        EPI_ROWS_BEGIN();
#pragma unroll
        for (int ai = 0; ai < 2; ++ai)
#pragma unroll
            for (int m = 0; m < 4; ++m) { const int row = row0 + ai * 128 + m * 16;
                const f32x4 s0 = *(const f32x4*)(SSQ + (size_t)row * 16 + u.gi * 8), s1 = *(const f32x4*)(SSQ + (size_t)row * 16 + u.gi * 8 + 4);
                const float ss = ((s0[0] + s0[1]) + (s0[2] + s0[3])) + ((s1[0] + s1[1]) + (s1[2] + s1[3]));
                const float rs = rsqrtf(ss * (1.0f / 512.0f) + EPS);
                if (u.gi == 0) {
#pragma unroll
                    for (int bj = 0; bj < 2; ++bj) { const int col = u.pn * 256 + bj * 128 + cl0; const int w = col % DQK;
                        f32x4 a = acc[ai][bj][m][0] * rs, b = acc[ai][bj][m][1] * rs;
                        if (w >= 128) rope8(a, b, ctab, stab, row, (w - 128) >> 1);
                        *(u32x4*)(Q + (size_t)row * NQUP + col) = pack8s(a, b, 1.f); }
                } else {
                    *(u32x4*)(KN + (size_t)row * D + u.pn * 128 + cl0) = pack8s(acc[ai][0][m][0], acc[ai][0][m][1], rs);
                    *(u32x4*)(V + (size_t)row * D + u.pn * 128 + cl0) = pack8s(acc[ai][1][m][0], acc[ai][1][m][1], rs);
                } }
    }
};
struct EpiMix {
    static constexpr bool PERM = true;
    bf16_t* MIX; float* SSM;
    __device__ __forceinline__ void operator()(const f32x4 (&acc)[2][2][4][2], const pg8::Unit& u, int wr, int wc, int fr, int fq) const {
        EPI_ROWS_BEGIN();
#pragma unroll
        for (int ai = 0; ai < 2; ++ai)
#pragma unroll
            for (int m = 0; m < 4; ++m) { const int row = row0 + ai * 128 + m * 16; float ss = 0.f;
#pragma unroll
                for (int bj = 0; bj < 2; ++bj) { *(u32x4*)(MIX + (size_t)row * D + u.pn * 256 + bj * 128 + cl0) = pack8s(acc[ai][bj][m][0], acc[ai][bj][m][1], 1.f); ss += sumsq8(acc[ai][bj][m][0], acc[ai][bj][m][1], 1.f); }
                ss += __shfl_xor(ss, 16); ss += __shfl_xor(ss, 32);
                if (fq == 0) SSM[(size_t)row * 32 + u.pn * 4 + wc] = ss; }
    }
};
__device__ __forceinline__ float gelu_tanh(float x) {
    const float y = 0.7978845608028654f * (x + 0.044715f * x * x * x);
    const float e = __builtin_amdgcn_exp2f(y * 2.8853900817779268f);
    const float t = 1.0f - 2.0f * __builtin_amdgcn_rcpf(1.0f + e);
    return 0.5f * x * (1.0f + t);
}
__device__ __forceinline__ float dpp_prev1(float prev, float cur) {
    const int y = __builtin_amdgcn_update_dpp(0, __float_as_int(prev), 0x121, 0xf, 0xf, false);
    return __int_as_float(__builtin_amdgcn_update_dpp(y, __float_as_int(cur), 0x111, 0xf, 0xf, false));
}
__device__ __forceinline__ float dpp_prev2(float prev, float cur) {
    const int y = __builtin_amdgcn_update_dpp(0, __float_as_int(prev), 0x122, 0xf, 0xf, false);
    return __int_as_float(__builtin_amdgcn_update_dpp(y, __float_as_int(cur), 0x112, 0xf, 0xf, false));
}
struct EpiFfnUpConv {
    static constexpr bool PERM = true;
    bf16_t* ACT; const float* rsh; const float* cw; const float* cb; LAS unsigned char* xch;
    __device__ __forceinline__ void operator()(f32x4 (&acc)[2][2][4][2], const pg8::Unit& u, int wr, int wc, int fr, int fq) const {
        const int cl0 = wc * 32 + 8 * fq; const int lr0 = 128 * wr + fr, grow0 = 254 * u.pm - 2 + lr0;
#pragma unroll
        for (int g = 0; g < 8; ++g) { const int grow = grow0 + 16 * g; const bool ok = (unsigned)grow < (unsigned)S; const float rs = ok ? rsh[ok ? grow : 0] : 0.f;
#pragma unroll
            for (int bj = 0; bj < 2; ++bj)
#pragma unroll
                for (int n = 0; n < 2; ++n)
#pragma unroll
                    for (int e = 0; e < 4; ++e) acc[g >> 2][bj][g & 3][n][e] = ok ? acc[g >> 2][bj][g & 3][n][e] * rs : 0.f; }
        LAS f32x4* X = (LAS f32x4*)xch + wc * 32;
        if (wr == 0 && fr >= 14) { LAS f32x4* d = X + ((fr - 14) * 4 + fq) * 4; d[0] = acc[1][0][3][0]; d[1] = acc[1][0][3][1]; d[2] = acc[1][1][3][0]; d[3] = acc[1][1][3][1]; }
        asm volatile("s_waitcnt lgkmcnt(0)" ::: "memory"); __builtin_amdgcn_s_barrier(); asm volatile("" ::: "memory");
        f32x4 hg[2], hu[2]; hg[0] = hg[1] = hu[0] = hu[1] = (f32x4){0.f, 0.f, 0.f, 0.f};
        if (wr == 1 && fr >= 14) { const LAS f32x4* d = X + ((fr - 14) * 4 + fq) * 4; hg[0] = d[0]; hg[1] = d[1]; hu[0] = d[2]; hu[1] = d[3]; }
        const int c0 = u.pn * 128 + cl0;
#pragma unroll
        for (int n = 0; n < 2; ++n) { const float* wg = cw + c0 + 4 * n; const float* wu = cw + FF + c0 + 4 * n;
            const f32x4 w0g = *(const f32x4*)(wg), w1g = *(const f32x4*)(wg + FF2), w2g = *(const f32x4*)(wg + 2 * FF2), bg = *(const f32x4*)(cb + c0 + 4 * n);
            const f32x4 w0u = *(const f32x4*)(wu), w1u = *(const f32x4*)(wu + FF2), w2u = *(const f32x4*)(wu + 2 * FF2), bu = *(const f32x4*)(cb + FF + c0 + 4 * n);
            f32x4 pg = hg[n], pu = hu[n];
#pragma unroll
            for (int g = 0; g < 8; ++g) { const f32x4 cg = acc[g >> 2][0][g & 3][n], cu = acc[g >> 2][1][g & 3][n]; f32x4 o;
#pragma unroll
                for (int e = 0; e < 4; ++e) {
                    const float gt = w2g[e] * cg[e] + w1g[e] * dpp_prev1(pg[e], cg[e]) + w0g[e] * dpp_prev2(pg[e], cg[e]) + bg[e];
                    const float up = w2u[e] * cu[e] + w1u[e] * dpp_prev1(pu[e], cu[e]) + w0u[e] * dpp_prev2(pu[e], cu[e]) + bu[e];
                    o[e] = gelu_tanh(gt) * up; }
                acc[g >> 2][0][g & 3][n] = o; pg = cg; pu = cu; asm volatile("" : "+v"(acc[g >> 2][0][g & 3][n])); SBAR(); } }
#pragma unroll
        for (int g = 0; g < 8; ++g) { const int lr = lr0 + 16 * g, grow = grow0 + 16 * g;
            if (lr >= 2 && grow < S) *(u32x4*)(ACT + (size_t)grow * FF + c0) = pack8s(acc[g >> 2][0][g & 3][0], acc[g >> 2][0][g & 3][1], 1.f); }
    }
};
struct EpiMobaKvq {
    static constexpr bool PERM = true;
    unsigned char* wsb; float* KMEAN; const float* rsh; int pn_off;
    __device__ __forceinline__ void operator()(const f32x4 (&acc)[2][2][4][2], const pg8::Unit& u, int wr, int wc, int fr, int fq) const {
        EPI_ROWS_BEGIN();
        const int pe = u.pn + pn_off;
        bf16_t* base = (bf16_t*)(wsb + (pe < 16 ? WS_KB + (size_t)(pe >> 3) * (WS_VB - WS_KB) : WS_Q)); const int ct = (pe & 7) * 256;
        f32x4 cs00 = (f32x4){0.f, 0.f, 0.f, 0.f}, cs01 = cs00, cs10 = cs00, cs11 = cs00;
#pragma unroll
        for (int ai = 0; ai < 2; ++ai)
#pragma unroll
            for (int m = 0; m < 4; ++m) { const int row = row0 + ai * 128 + m * 16; const float rs = rsh[row];
#pragma unroll
                for (int bj = 0; bj < 2; ++bj) *(u32x4*)(base + (size_t)row * D + ct + bj * 128 + cl0) = pack8s(acc[ai][bj][m][0], acc[ai][bj][m][1], rs);
                cs00 += acc[ai][0][m][0] * rs; cs01 += acc[ai][0][m][1] * rs; cs10 += acc[ai][1][m][0] * rs; cs11 += acc[ai][1][m][1] * rs; }
        if (pe < 8) {
#define KM_ADD(CS, bj, n) do { _Pragma("unroll") for (int e = 0; e < 4; ++e) { float v = CS[e]; v += __shfl_xor(v, 1); v += __shfl_xor(v, 2); v += __shfl_xor(v, 4); v += __shfl_xor(v, 8); \
                if (fr == 0) (void)__hip_atomic_fetch_add(KMEAN + (size_t)u.pm * D + ct + (bj) * 128 + cl0 + (n) * 4 + e, v, __ATOMIC_RELAXED, __HIP_MEMORY_SCOPE_AGENT); } } while (0)
            KM_ADD(cs00, 0, 0); KM_ADD(cs01, 0, 1); KM_ADD(cs10, 1, 0); KM_ADD(cs11, 1, 1);
#undef KM_ADD
        }
    }
};

namespace att {
constexpr int V_OFF = 0, KN_OFF = 16384, KR_OFF = 32768, BUF_BYTES = 40960;
constexpr int WS_OFF = 2 * BUF_BYTES, BT_OFF = WS_OFF + 8 * 64 * 4, ATT_LDS = BT_OFF + 512;
#define KSWZ(row, colB) ((row) * 256 + ((colB) ^ (((row) & 7) << 4)))
#define RSWZ(row, colB) ((row) * 128 + ((colB) ^ (((row) & 7) << 4)))
__device__ __forceinline__ int v_st(int k, int c) { const int kk = (k & ~0xC) | ((k & 4) << 1) | ((k & 8) >> 1); return ((kk >> 3) * 4 + (c >> 5)) * 512 + ((kk & 7) * 32 + (c & 31)) * 2; }
__device__ __forceinline__ int v_rd_base(int lane) { return ((lane & 3) << 3) | (((lane >> 2) & 3) << 6) | (((lane >> 4) & 1) << 5) | (((lane >> 5) & 1) << 8); }
constexpr int v_rd_off(int d0, int ks, int half) { return d0 * 512 + ks * 4096 + half * 2048; }
__device__ __forceinline__ int crow(int r, int hi) { return (r & 3) + 8 * (r >> 2) + 4 * hi; }

struct Args { const bf16_t* Q; const bf16_t* K; const bf16_t* KR; const bf16_t* V; bf16_t* O; const unsigned* SEL; const float* relb; const int* pos; };

template <int BUF>
__device__ __forceinline__ void pv_tile(f32x16* o, int vb0, bf16x8 pa0, bf16x8 pa1, bf16x8 pa2, bf16x8 pa3) {
#define TRRD(dst, off) asm volatile("ds_read_b64_tr_b16 %0, %1 offset:%2" : "=&v"(dst) : "v"(vb0), "i"(off) : "memory")
#define PV_D0(d0) do { s16x4 l0, l1, l2, l3, h0, h1, h2, h3; constexpr int b_ = BUF * BUF_BYTES + V_OFF + v_rd_off(d0, 0, 0); \
        TRRD(l0, b_); TRRD(h0, b_ + 2048); TRRD(l1, b_ + 4096); TRRD(h1, b_ + 6144); TRRD(l2, b_ + 8192); TRRD(h2, b_ + 10240); TRRD(l3, b_ + 12288); TRRD(h3, b_ + 14336); \
        asm volatile("s_waitcnt lgkmcnt(0)" ::: "memory"); SBAR(); \
        o[d0] = __builtin_amdgcn_mfma_f32_32x32x16_bf16(pa0, (bf16x8){l0[0], l0[1], l0[2], l0[3], h0[0], h0[1], h0[2], h0[3]}, o[d0], 0, 0, 0); \
        o[d0] = __builtin_amdgcn_mfma_f32_32x32x16_bf16(pa1, (bf16x8){l1[0], l1[1], l1[2], l1[3], h1[0], h1[1], h1[2], h1[3]}, o[d0], 0, 0, 0); \
        o[d0] = __builtin_amdgcn_mfma_f32_32x32x16_bf16(pa2, (bf16x8){l2[0], l2[1], l2[2], l2[3], h2[0], h2[1], h2[2], h2[3]}, o[d0], 0, 0, 0); \
        o[d0] = __builtin_amdgcn_mfma_f32_32x32x16_bf16(pa3, (bf16x8){l3[0], l3[1], l3[2], l3[3], h3[0], h3[1], h3[2], h3[3]}, o[d0], 0, 0, 0); } while (0)
    PV_D0(0); PV_D0(1); PV_D0(2); PV_D0(3);
#undef PV_D0
#undef TRRD
}

template <bool MOBA>
__device__ __forceinline__ void attn_unit(LAS unsigned char* lds, const Args& T, int h, int qb) {
    constexpr int NDQ = MOBA ? 8 : 12, QPITCH = MOBA ? 2048 : 3072, HD = MOBA ? 128 : 192;
    constexpr float SCALE = MOBA ? 0.08838834764831845f : 0.07216878364870323f;
    constexpr float C2 = 1.4426950408889634f * SCALE, THR = 8.f;
    const int tid = opaque_tid(), wid = __builtin_amdgcn_readfirstlane(tid >> 6), lane = tid & 63, r32 = lane & 31, hi = lane >> 5;
    const int q0 = qb * 256, qlo = q0 + wid * 32, qrow = qlo + r32, NT = 4 * (qb + 1), own = qb;
    LAS float* wsf = (LAS float*)(lds + WS_OFF) + wid * 64; LAS float* li_l = wsf; LAS float* al_l = wsf + 32;
    LAS float* btab = (LAS float*)(lds + BT_OFF);
    bf16x8 qr[NDQ];
    { const bf16_t* Qp = T.Q + (size_t)qrow * QPITCH + h * HD + hi * 8;
#pragma unroll
      for (int d0 = 0; d0 < NDQ; ++d0) qr[d0] = *(const bf16x8*)(Qp + d0 * 16); }
    unsigned selm = 0u; int pq = 0;
    if (MOBA) { selm = T.SEL[(size_t)qrow * NH + h]; pq = T.pos[qrow];
        if (tid < 128) { int n = tid, b = n;
            if (n >= 16) { b = 16 + (int)(logf((float)n * (1.0f / 16.0f)) / 2.0794415416798357f * 16.0f); b = b > 31 ? 31 : b; }
            btab[tid] = (T.relb[b * NH + h] - T.relb[31 * NH + h]) * (1.0f / SCALE); } }
    unsigned vk[2], vv[2], vr = 0u;
#pragma unroll
    for (int i = 0; i < 2; ++i) { const int pb = (wid + 8 * i) * 1024 + lane * 16;
        { const int row = pb >> 8, ch = ((pb & 255) >> 4) ^ (row & 7); vk[i] = (unsigned)(row * (D * 2) + ch * 16); }
        { const int sub = pb >> 9, w = (pb & 511) >> 1, kk = (sub >> 2) * 8 + (w >> 5), c = (sub & 3) * 32 + (w & 31);
          const int k = (kk & ~0xC) | ((kk & 4) << 1) | ((kk & 8) >> 1); vv[i] = (unsigned)(k * (D * 2) + c * 2); } }
    if (!MOBA) { const int pb = wid * 1024 + lane * 16, row = pb >> 7, ch = ((pb & 127) >> 4) ^ (row & 7); vr = (unsigned)(row * 128 + ch * 16); }
    const char* Kg = (const char*)(T.K + h * 128); const char* Vg = (const char*)(T.V + h * 128); const char* Rg = (const char*)T.KR;
#define GLDS(g, l) __builtin_amdgcn_global_load_lds((const unsigned*)(g), (LAS unsigned*)(l), 16, 0, 0)
#define DMA_TILE(kb, bf) do { const char* kt_ = Kg + (size_t)(kb) * (D * 2); const char* vt_ = Vg + (size_t)(kb) * (D * 2); \
        GLDS(kt_ + vk[0], lds + (bf) * BUF_BYTES + KN_OFF + wid * 1024); GLDS(kt_ + vk[1], lds + (bf) * BUF_BYTES + KN_OFF + (wid + 8) * 1024); \
        GLDS(vt_ + vv[0], lds + (bf) * BUF_BYTES + V_OFF + wid * 1024); GLDS(vt_ + vv[1], lds + (bf) * BUF_BYTES + V_OFF + (wid + 8) * 1024); \
        if (!MOBA) GLDS(Rg + (size_t)(kb) * 128 + vr, lds + (bf) * BUF_BYTES + KR_OFF + wid * 1024); } while (0)
    const int vb0 = (int)(unsigned)(uintptr_t)(lds) + v_rd_base(lane);
    int kna[4], kra[4];
#pragma unroll
    for (int dd = 0; dd < 4; ++dd) { kna[dd] = KN_OFF + KSWZ(r32, (dd * 16 + hi * 8) * 2); kra[dd] = KR_OFF + RSWZ(r32, (dd * 16 + hi * 8) * 2); }
    float m_reg = -1e30f, l_reg = 0.f; f32x16 o[4];
#pragma unroll
    for (int d = 0; d < 4; ++d) o[d] = f32x16{};
    DMA_TILE(0, 0); VM_WAIT(); __syncthreads();

#define ATT_STEP(t, BUF) do { const int kb = (t) * 64; \
        if ((t) + 1 < NT) DMA_TILE(kb + 64, (BUF) ^ 1); \
        bool keep = true; const int blk = (t) >> 2; \
        if (MOBA && blk < own) keep = ((selm >> blk) & 1u) != 0u; \
        if (!MOBA || __any(keep)) { \
            f32x16 p0 = f32x16{}, p1 = f32x16{}; \
            _Pragma("unroll") for (int d0 = 0; d0 < 8; ++d0) { const LAS unsigned char* a = lds + (BUF) * BUF_BYTES + kna[d0 & 3] + (d0 >> 2) * 128; \
                const bf16x8 b0 = *(const LAS bf16x8*)a, b1 = *(const LAS bf16x8*)(a + 32 * 256); \
                p0 = __builtin_amdgcn_mfma_f32_32x32x16_bf16(b0, qr[d0], p0, 0, 0, 0); p1 = __builtin_amdgcn_mfma_f32_32x32x16_bf16(b1, qr[d0], p1, 0, 0, 0); } \
            if (!MOBA) { _Pragma("unroll") for (int d0 = 0; d0 < 4; ++d0) { const LAS unsigned char* a = lds + (BUF) * BUF_BYTES + kra[d0]; \
                const bf16x8 b0 = *(const LAS bf16x8*)a, b1 = *(const LAS bf16x8*)(a + 32 * 128); \
                p0 = __builtin_amdgcn_mfma_f32_32x32x16_bf16(b0, qr[(NDQ - 4) + d0], p0, 0, 0, 0); p1 = __builtin_amdgcn_mfma_f32_32x32x16_bf16(b1, qr[(NDQ - 4) + d0], p1, 0, 0, 0); } } \
            const float NEGINF = -__builtin_inff(); \
            if (MOBA) { \
                if (!keep) { _Pragma("unroll") for (int r = 0; r < 16; ++r) { p0[r] = NEGINF; p1[r] = NEGINF; } } \
                if (T.pos[qlo] - T.pos[kb + 63] < 128) {     \
                    _Pragma("unroll") for (int g = 0; g < 4; ++g) { const i32x4 pk0 = *(const i32x4*)(T.pos + kb + 8 * g + 4 * hi), pk1 = *(const i32x4*)(T.pos + kb + 32 + 8 * g + 4 * hi); \
                        _Pragma("unroll") for (int e = 0; e < 4; ++e) { const int d0_ = pq - pk0[e], d1_ = pq - pk1[e]; \
                            if ((unsigned)d0_ < 128u) p0[4 * g + e] += btab[d0_]; if ((unsigned)d1_ < 128u) p1[4 * g + e] += btab[d1_]; } } } \
            } \
            if (kb + 63 > qlo) { _Pragma("unroll") for (int r = 0; r < 16; ++r) { const int c = kb + crow(r, hi); if (c > qrow) p0[r] = NEGINF; if (c + 32 > qrow) p1[r] = NEGINF; } } \
            float pmax = p0[0]; _Pragma("unroll") for (int r = 1; r < 16; ++r) pmax = fmaxf(pmax, p0[r]); _Pragma("unroll") for (int r = 0; r < 16; ++r) pmax = fmaxf(pmax, p1[r]); \
            { auto rr_ = __builtin_amdgcn_permlane32_swap(__float_as_uint(pmax), __float_as_uint(pmax), false, false); pmax = fmaxf(__uint_as_float(rr_[0]), __uint_as_float(rr_[1])); } \
            float mn, alpha; \
            if (__all((pmax - m_reg) * SCALE <= THR)) { mn = m_reg; alpha = 1.f; } \
            else { mn = fmaxf(m_reg, pmax); alpha = __builtin_amdgcn_exp2f((m_reg - mn) * C2); m_reg = mn; } \
            const float mnL = -mn * C2; \
            _Pragma("unroll") for (int r = 0; r < 16; ++r) { p0[r] = __builtin_amdgcn_exp2f(fmaf(p0[r], C2, mnL)); p1[r] = __builtin_amdgcn_exp2f(fmaf(p1[r], C2, mnL)); } \
            float ps = 0.f; _Pragma("unroll") for (int r = 0; r < 16; ++r) ps += p0[r]; _Pragma("unroll") for (int r = 0; r < 16; ++r) ps += p1[r]; \
            { auto rr_ = __builtin_amdgcn_permlane32_swap(__float_as_uint(ps), __float_as_uint(ps), false, false); ps = __uint_as_float(rr_[0]) + __uint_as_float(rr_[1]); } \
            l_reg = l_reg * alpha + ps; \
            bf16x8 pa0, pa1, pa2, pa3; \
            PK4(p0, 0, pa0); PK4(p0, 8, pa1); PK4(p1, 0, pa2); PK4(p1, 8, pa3); \
            if (__any(alpha < 1.f)) { if (hi == 0) al_l[r32] = alpha; LDS_WAIT(); \
                _Pragma("unroll") for (int d_ = 0; d_ < 4; ++d_) _Pragma("unroll") for (int r = 0; r < 16; ++r) o[d_][r] *= al_l[crow(r, hi)]; } \
            SBAR(); pv_tile<BUF>(o, vb0, pa0, pa1, pa2, pa3); \
        } \
        VM_WAIT(); __syncthreads(); } while (0)
#define PK4(P, B_, OUT) do { unsigned a0_ = cvt_pk_bf16(P[B_ + 0], P[B_ + 1]), a1_ = cvt_pk_bf16(P[B_ + 2], P[B_ + 3]); \
        unsigned b0_ = cvt_pk_bf16(P[B_ + 4], P[B_ + 5]), b1_ = cvt_pk_bf16(P[B_ + 6], P[B_ + 7]); \
        auto r0_ = __builtin_amdgcn_permlane32_swap(a0_, b0_, false, false); auto r1_ = __builtin_amdgcn_permlane32_swap(a1_, b1_, false, false); \
        u32x4 w_ = {r0_[0], r1_[0], r0_[1], r1_[1]}; OUT = __builtin_bit_cast(bf16x8, w_); } while (0)

    for (int t = 0; t < NT; t += 2) { ATT_STEP(t, 0); ATT_STEP(t + 1, 1); }
#undef PK4
#undef ATT_STEP
#undef DMA_TILE
#undef GLDS
    if (hi == 0) li_l[r32] = l_reg; LDS_WAIT();
    bf16_t* Ow = T.O + (size_t)qlo * D + h * 128;
#pragma unroll
    for (int r = 0; r < 16; ++r) { const int orow = crow(r, hi); const float rl = __builtin_amdgcn_rcpf(li_l[orow]);
#pragma unroll
        for (int d0 = 0; d0 < 4; ++d0) { const float v = o[d0][r] * rl; const float vn = __shfl_xor(v, 1);
            if ((r32 & 1) == 0) *(unsigned*)(Ow + (size_t)orow * D + d0 * 32 + r32) = cvt_pk_bf16(v, vn); } }
    __syncthreads();
}

constexpr int DT_OFF = ATT_LDS, PREF_OFF = DT_OFF + 1024, MOBA_LDS = PREF_OFF + 2064;
struct MobaArgs { const bf16_t* Q; const bf16_t* K; const bf16_t* V; const unsigned short* LIST; bf16_t* OP; float* MLP; const float* relb; const int* pos; };
__device__ __forceinline__ void moba_piece(LAS unsigned char* lds, const MobaArgs& T, int h, int n, int j, int cnt, bool own_item) {
    constexpr float SCALE = 0.08838834764831845f, C2 = 1.4426950408889634f * SCALE, THR = 8.f;
    const int tid = opaque_tid(), wid = __builtin_amdgcn_readfirstlane(tid >> 6), lane = tid & 63, r32 = lane & 31, hi = lane >> 5;
    LAS float* wsf = (LAS float*)(lds + WS_OFF) + wid * 64; LAS float* li_l = wsf; LAS float* al_l = wsf + 32;
    LAS float* btab = (LAS float*)(lds + BT_OFF); LAS int* dtab = (LAS int*)(lds + DT_OFF) + wid * 32;
    int q, slot; bool valid;
    if (own_item) { q = n * 256 + wid * 32 + r32; slot = 3; valid = true; }
    else { const int idx = j * 256 + wid * 32 + r32; valid = idx < cnt; const unsigned e = valid ? (unsigned)T.LIST[((size_t)(h * 32 + n) << 13) + idx] : 0u; q = (int)(e & 8191u); slot = (int)(e >> 13); }
    const int dmine = valid ? ((slot * S + q) * NH + h) : -1;
    const int pq = T.pos[q]; const bool adj = (q >> 8) == n + 1;
    const int qlo = n * 256 + wid * 32;
    bf16x8 qr[8];
    { const bf16_t* Qp = T.Q + (size_t)q * D + h * 128 + hi * 8;
#pragma unroll
      for (int d0 = 0; d0 < 8; ++d0) qr[d0] = *(const bf16x8*)(Qp + d0 * 16); }
    if (tid < 128) { int nn = tid, b = nn;
        if (nn >= 16) { b = 16 + (int)(logf((float)nn * (1.0f / 16.0f)) / 2.0794415416798357f * 16.0f); b = b > 31 ? 31 : b; }
        btab[tid] = (T.relb[b * NH + h] - T.relb[31 * NH + h]) * (1.0f / SCALE); }
    unsigned vk[2], vv[2];
#pragma unroll
    for (int i = 0; i < 2; ++i) { const int pb = (wid + 8 * i) * 1024 + lane * 16;
        { const int row = pb >> 8, ch = ((pb & 255) >> 4) ^ (row & 7); vk[i] = (unsigned)(row * (D * 2) + ch * 16); }
        { const int sub = pb >> 9, w = (pb & 511) >> 1, kk = (sub >> 2) * 8 + (w >> 5), c = (sub & 3) * 32 + (w & 31);
          const int k = (kk & ~0xC) | ((kk & 4) << 1) | ((kk & 8) >> 1); vv[i] = (unsigned)(k * (D * 2) + c * 2); } }
    const char* Kg = (const char*)(T.K + (size_t)n * 256 * D + h * 128); const char* Vg = (const char*)(T.V + (size_t)n * 256 * D + h * 128);
#define GLDS(g, l) __builtin_amdgcn_global_load_lds((const unsigned*)(g), (LAS unsigned*)(l), 16, 0, 0)
#define DMA_TILE(kb, bf) do { const char* kt_ = Kg + (size_t)(kb) * (D * 2); const char* vt_ = Vg + (size_t)(kb) * (D * 2); \
        GLDS(kt_ + vk[0], lds + (bf) * BUF_BYTES + KN_OFF + wid * 1024); GLDS(kt_ + vk[1], lds + (bf) * BUF_BYTES + KN_OFF + (wid + 8) * 1024); \
        GLDS(vt_ + vv[0], lds + (bf) * BUF_BYTES + V_OFF + wid * 1024); GLDS(vt_ + vv[1], lds + (bf) * BUF_BYTES + V_OFF + (wid + 8) * 1024); } while (0)
    const int vb0 = (int)(unsigned)(uintptr_t)(lds) + v_rd_base(lane);
    int kna[4];
#pragma unroll
    for (int dd = 0; dd < 4; ++dd) kna[dd] = KN_OFF + KSWZ(r32, (dd * 16 + hi * 8) * 2);
    float m_reg = -1e30f, l_reg = 0.f; f32x16 o[4];
#pragma unroll
    for (int d = 0; d < 4; ++d) o[d] = f32x16{};
    DMA_TILE(0, 0); VM_WAIT(); __syncthreads();
#define PK4(P, B_, OUT) do { unsigned a0_ = cvt_pk_bf16(P[B_ + 0], P[B_ + 1]), a1_ = cvt_pk_bf16(P[B_ + 2], P[B_ + 3]); \
        unsigned b0_ = cvt_pk_bf16(P[B_ + 4], P[B_ + 5]), b1_ = cvt_pk_bf16(P[B_ + 6], P[B_ + 7]); \
        auto r0_ = __builtin_amdgcn_permlane32_swap(a0_, b0_, false, false); auto r1_ = __builtin_amdgcn_permlane32_swap(a1_, b1_, false, false); \
        u32x4 w_ = {r0_[0], r1_[0], r0_[1], r1_[1]}; OUT = __builtin_bit_cast(bf16x8, w_); } while (0)
#define MOBA_STEP(t, BUF) do { const int kb = (t) * 64;     \
        if ((t) + 1 < 4) DMA_TILE(kb + 64, (BUF) ^ 1); \
        f32x16 p0 = f32x16{}, p1 = f32x16{}; \
        _Pragma("unroll") for (int d0 = 0; d0 < 8; ++d0) { const LAS unsigned char* a = lds + (BUF) * BUF_BYTES + kna[d0 & 3] + (d0 >> 2) * 128; \
            const bf16x8 b0 = *(const LAS bf16x8*)a, b1 = *(const LAS bf16x8*)(a + 32 * 256); \
            p0 = __builtin_amdgcn_mfma_f32_32x32x16_bf16(b0, qr[d0], p0, 0, 0, 0); p1 = __builtin_amdgcn_mfma_f32_32x32x16_bf16(b1, qr[d0], p1, 0, 0, 0); } \
        const float NEGINF = -__builtin_inff(); const int kabs = n * 256 + kb;     \
        const bool band = own_item ? (T.pos[qlo] - T.pos[kabs + 63] < 128) : ((t) >= 2 && __any(adj)); \
        if (band) { \
            _Pragma("unroll") for (int g = 0; g < 4; ++g) { const i32x4 pk0 = *(const i32x4*)(T.pos + kabs + 8 * g + 4 * hi), pk1 = *(const i32x4*)(T.pos + kabs + 32 + 8 * g + 4 * hi); \
                _Pragma("unroll") for (int e = 0; e < 4; ++e) { const int d0_ = pq - pk0[e], d1_ = pq - pk1[e]; \
                    if ((unsigned)d0_ < 128u) p0[4 * g + e] += btab[d0_]; if ((unsigned)d1_ < 128u) p1[4 * g + e] += btab[d1_]; } } } \
        if (own_item && kabs + 63 > qlo) { _Pragma("unroll") for (int r = 0; r < 16; ++r) { const int c = kabs + crow(r, hi); if (c > q) p0[r] = NEGINF; if (c + 32 > q) p1[r] = NEGINF; } } \
        float pmax = p0[0]; _Pragma("unroll") for (int r = 1; r < 16; ++r) pmax = fmaxf(pmax, p0[r]); _Pragma("unroll") for (int r = 0; r < 16; ++r) pmax = fmaxf(pmax, p1[r]); \
        { auto rr_ = __builtin_amdgcn_permlane32_swap(__float_as_uint(pmax), __float_as_uint(pmax), false, false); pmax = fmaxf(__uint_as_float(rr_[0]), __uint_as_float(rr_[1])); } \
        float mn, alpha; \
        if (__all((pmax - m_reg) * SCALE <= THR)) { mn = m_reg; alpha = 1.f; } \
        else { mn = fmaxf(m_reg, pmax); alpha = __builtin_amdgcn_exp2f((m_reg - mn) * C2); m_reg = mn; } \
        const float mnL = -mn * C2; \
        _Pragma("unroll") for (int r = 0; r < 16; ++r) { p0[r] = __builtin_amdgcn_exp2f(fmaf(p0[r], C2, mnL)); p1[r] = __builtin_amdgcn_exp2f(fmaf(p1[r], C2, mnL)); } \
        float ps = 0.f; _Pragma("unroll") for (int r = 0; r < 16; ++r) ps += p0[r]; _Pragma("unroll") for (int r = 0; r < 16; ++r) ps += p1[r]; \
        { auto rr_ = __builtin_amdgcn_permlane32_swap(__float_as_uint(ps), __float_as_uint(ps), false, false); ps = __uint_as_float(rr_[0]) + __uint_as_float(rr_[1]); } \
        l_reg = l_reg * alpha + ps; \
        bf16x8 pa0, pa1, pa2, pa3; \
        PK4(p0, 0, pa0); PK4(p0, 8, pa1); PK4(p1, 0, pa2); PK4(p1, 8, pa3); \
        if (__any(alpha < 1.f)) { if (hi == 0) al_l[r32] = alpha; LDS_WAIT(); \
            _Pragma("unroll") for (int d_ = 0; d_ < 4; ++d_) _Pragma("unroll") for (int r = 0; r < 16; ++r) o[d_][r] *= al_l[crow(r, hi)]; } \
        SBAR(); pv_tile<BUF>(o, vb0, pa0, pa1, pa2, pa3); \
        VM_WAIT(); __syncthreads(); } while (0)
    MOBA_STEP(0, 0); MOBA_STEP(1, 1); MOBA_STEP(2, 0); MOBA_STEP(3, 1);
#undef MOBA_STEP
#undef PK4
#undef DMA_TILE
#undef GLDS
    if (hi == 0) { li_l[r32] = l_reg; dtab[r32] = dmine; if (dmine >= 0) *(f32x2*)(T.MLP + 2 * (size_t)dmine) = (f32x2){m_reg, l_reg}; }
    LDS_WAIT();
#pragma unroll
    for (int r = 0; r < 16; ++r) { const int orow = crow(r, hi); const float rl = __builtin_amdgcn_rcpf(li_l[orow]); const int dd = dtab[orow];
#pragma unroll
        for (int d0 = 0; d0 < 4; ++d0) { const float v = o[d0][r] * rl; const float vn = __shfl_xor(v, 1);
            if ((r32 & 1) == 0 && dd >= 0) *(unsigned*)(T.OP + (size_t)dd * 128 + d0 * 32 + r32) = cvt_pk_bf16(v, vn); } }
    __syncthreads();
}
__device__ __forceinline__ void moba_phase(LAS unsigned char* lds, const MobaArgs& T, const unsigned* cntl, int vcu, int G) {
    LAS unsigned* pref = (LAS unsigned*)(lds + PREF_OFF);
    { const int tid = opaque_tid(), lane = tid & 63;
      if (tid < 64) { unsigned c[8], sum = 0u;
#pragma unroll
          for (int i = 0; i < 8; ++i) { c[i] = (__hip_atomic_load(cntl + lane * 8 + i, __ATOMIC_RELAXED, __HIP_MEMORY_SCOPE_AGENT) + 255u) >> 8; sum += c[i]; }
          unsigned inc = sum;
#pragma unroll
          for (int o = 1; o < 64; o <<= 1) { const unsigned t = __shfl_up(inc, o); if (lane >= o) inc += t; }
          unsigned ex = inc - sum;
#pragma unroll
          for (int i = 0; i < 8; ++i) { pref[lane * 8 + i] = ex; ex += c[i]; }
          if (lane == 63) pref[512] = ex; }
      __syncthreads(); }
    const int NSEL = (int)pref[512];
    for (int it = vcu; it < NSEL + 512; it += G) {
        if (it < NSEL) { int lo = 0, hi2 = 512;
            while (hi2 - lo > 1) { const int mid = (lo + hi2) >> 1; if ((int)pref[mid] <= it) lo = mid; else hi2 = mid; }
            const int cn = (int)__hip_atomic_load(cntl + lo, __ATOMIC_RELAXED, __HIP_MEMORY_SCOPE_AGENT);
            moba_piece(lds, T, lo >> 5, lo & 31, it - (int)pref[lo], cn, false);
        } else { const int x = it - NSEL; moba_piece(lds, T, x >> 5, x & 31, 0, 256, true); }
    }
}
}

#define XB_TMO      128
#define XB_XCNT(j)  (256  + 64 * (j))
#define XB_XSUB(j)  (1280 + 64 * (j))
#define XB_XGEN(j)  (2304 + 64 * (j))
#define XB_TOP      3328
#define XB_TOPGEN   3392
#define XCD_BAR_WORDS 3456
#define XB_SPIN_CAP (1u << 18)
__device__ __forceinline__ unsigned xb_ld(unsigned* p)              { return __hip_atomic_load(p, __ATOMIC_RELAXED, __HIP_MEMORY_SCOPE_AGENT); }
__device__ __forceinline__ unsigned xb_add(unsigned* p, unsigned v) { return __hip_atomic_fetch_add(p, v, __ATOMIC_RELAXED, __HIP_MEMORY_SCOPE_AGENT); }
__device__ __forceinline__ unsigned xb_xcc_id() { return (unsigned)__builtin_amdgcn_s_getreg((3 << 11) | 20) & 0xFu; }
#define XB_SPIN(cond, bar) do { unsigned _sp = 0; while (cond) { __builtin_amdgcn_s_sleep(1); \
    if ((++_sp & 255u) == 0u) { if (xb_ld(&(bar)[XB_TMO])) break; if (_sp > XB_SPIN_CAP) { atomicAdd(&(bar)[XB_TMO], 1u); break; } } } } while (0)
struct XcdBarrier { unsigned* bar; unsigned x; volatile LAS unsigned* st; };
__device__ __forceinline__ XcdBarrier xcd_barrier_post(unsigned* bar, volatile LAS unsigned* st) {
    XcdBarrier b; b.bar = bar; b.x = xb_xcc_id(); b.st = st;
    if (threadIdx.x == 0) (void)xb_add(&bar[XB_XCNT(b.x)], 1u);
    return b;
}
__device__ __forceinline__ void xcd_barrier_complete(unsigned* bar, unsigned x, unsigned& nloc, unsigned& nx) {
    const unsigned G = gridDim.x * gridDim.y * gridDim.z;
    unsigned sum, cnt, mine, sp = 0u;
    for (;;) {
        sum = 0u; cnt = 0u; mine = 0u;
#pragma unroll
        for (unsigned j = 0; j < 16; ++j) { const unsigned c = xb_ld(&bar[XB_XCNT(j)]); sum += c; cnt += (c > 0u) ? 1u : 0u; mine = (j == x) ? c : mine; }
        if (sum == G) break;
        __builtin_amdgcn_s_sleep(1);
        if ((++sp & 255u) == 0u) { if (xb_ld(&bar[XB_TMO])) break; if (sp > XB_SPIN_CAP) { atomicAdd(&bar[XB_TMO], 1u); break; } }
    }
    nloc = mine > 0u ? mine : 1u; nx = cnt > 0u ? cnt : 1u;
}
__device__ __forceinline__ void xcd_barrier(const XcdBarrier& b) {
    asm volatile("s_waitcnt vmcnt(0)" ::: "memory");
    __syncthreads();
    if (threadIdx.x == 0) {
        unsigned* bar = b.bar;
        __builtin_amdgcn_s_waitcnt(0);
        unsigned nloc = b.st[0], nx = b.st[1];
        if (nloc == 0u) { xcd_barrier_complete(bar, b.x, nloc, nx); b.st[0] = nloc; b.st[1] = nx; }
        const unsigned old = xb_add(&bar[XB_XSUB(b.x)], 1u);
        const unsigned gen = old / nloc;
        if (old + 1u == (gen + 1u) * nloc) {
            __builtin_amdgcn_fence(__ATOMIC_RELEASE, "agent");
            asm volatile("s_waitcnt vmcnt(0)" ::: "memory");
            const unsigned og = xb_add(&bar[XB_TOP], 1u);
            const unsigned tg = og / nx;
            if (og + 1u == (tg + 1u) * nx) xb_add(&bar[XB_TOPGEN], 1u);
            else XB_SPIN(xb_ld(&bar[XB_TOPGEN]) == tg, bar);
            __builtin_amdgcn_fence(__ATOMIC_ACQUIRE, "agent");
            xb_add(&bar[XB_XGEN(b.x)], 1u);
            asm volatile("s_waitcnt vmcnt(0)" ::: "memory");
        } else {
            XB_SPIN(xb_ld(&bar[XB_XGEN(b.x)]) == gen, bar);
            __builtin_amdgcn_fence(__ATOMIC_ACQUIRE, "agent");
            asm volatile("s_waitcnt vmcnt(0)" ::: "memory");
        }
    }
    __syncthreads();
}

struct Params {
    const float* x; const int* pos; const float* gains; const float* a_w_in; const float* a_q_norm; const float* a_w_q_up; const float* a_kv_norm; const float* a_w_kv_up;
    const float* a_w_o; const float* b_kv_norm; const float* b_w_kv; const float* b_w_q; const float* b_w_o; const float* rel_bias; const float* ffn_w_in; const float* ffn_conv_w;
    const float* ffn_conv_b; const float* ffn_w_out; float* out; unsigned char* ws; int ph_lo, ph_hi;
};

struct WDesc { const float* src; const float* gain; bf16_t* dst; int K, Nsrc, Ndst, map; };
__device__ __forceinline__ int colmap(int map, int n) {
    if (map == 1) { if (n < 1024) return n; if (n >= NIN) return -1; const int j = n - 1024; return 1024 + (j >> 1) + (j & 1) * 32; }
    if (map == 2) { const int hh = n / DQK, w = n % DQK; if (w < 128) return n; const int j = w - 128; return hh * DQK + 128 + (j >> 1) + (j & 1) * 32; }
    if (map == 3) { const int t = n >> 8, j = n & 255; return j < 128 ? t * 128 + j : FF + t * 128 + (j - 128); }
    return n;
}
__device__ __forceinline__ WDesc wdesc(const Params& p, int i) {
    WDesc w; bf16_t* ws = (bf16_t*)p.ws; w.gain = nullptr; w.map = 0;
    if (i < 2) { w.src = p.a_w_in + (size_t)i * D * NIN; w.gain = p.gains + (size_t)(i * 4 + 0) * D; w.dst = (bf16_t*)(p.ws + WS_WIN) + (size_t)i * NINP * D; w.K = D; w.Nsrc = NIN; w.Ndst = NINP; w.map = 1; }
    else if (i < 4) { const int l = i - 2; w.src = p.a_w_q_up + (size_t)l * QL * NQUP; w.gain = p.a_q_norm + l * QL; w.dst = (bf16_t*)(p.ws + WS_WUPG) + (size_t)l * 7168 * 512; w.K = QL; w.Nsrc = NQUP; w.Ndst = NQUP; w.map = 2; }
    else if (i < 6) { const int l = i - 4; w.src = p.a_w_kv_up + (size_t)l * KVL * NKVUP; w.gain = p.a_kv_norm + l * KVL; w.dst = (bf16_t*)(p.ws + WS_WUPG) + (size_t)l * 7168 * 512 + (size_t)NQUP * 512; w.K = KVL; w.Nsrc = NKVUP; w.Ndst = NKVUP; }
    else if (i < 10) { const int l = i - 6; w.src = (l < 2 ? p.a_w_o + (size_t)l * D * D : p.b_w_o + (size_t)(l - 2) * D * D); w.dst = (bf16_t*)(p.ws + WS_WO) + (size_t)l * D * D; w.K = D; w.Nsrc = D; w.Ndst = D; }
    else if (i == 10) { w.src = p.b_w_kv; w.gain = p.b_kv_norm; w.dst = (bf16_t*)(p.ws + WS_WKVQ); w.K = D; w.Nsrc = 4096; w.Ndst = 4096; }
    else if (i == 11) { w.src = p.b_w_q; w.gain = p.gains + (size_t)(2 * 4 + 0) * D; w.dst = (bf16_t*)(p.ws + WS_WKVQ) + (size_t)4096 * D; w.K = D; w.Nsrc = D; w.Ndst = D; }
    else if (i == 12) { w.src = p.b_w_q + (size_t)D * D; w.gain = p.gains + (size_t)(3 * 4 + 0) * D; w.dst = (bf16_t*)(p.ws + WS_WQ1); w.K = D; w.Nsrc = D; w.Ndst = D; }
    else if (i < 17) { const int l = i - 13; w.src = p.ffn_w_in + (size_t)l * D * FF2; w.gain = p.gains + (size_t)(l * 4 + 2) * D; w.dst = (bf16_t*)(p.ws + WS_WUP) + (size_t)l * FF2 * D; w.K = D; w.Nsrc = FF2; w.Ndst = FF2; w.map = 3; }
    else { const int l = i - 17; w.src = p.ffn_w_out + (size_t)l * FF * D; w.dst = (bf16_t*)(p.ws + WS_WDN) + (size_t)l * D * FF; w.K = FF; w.Nsrc = D; w.Ndst = D; }
    (void)ws; return w;
}
constexpr int NWDESC = 21;
__device__ __forceinline__ void transpose_item(const WDesc& w, LAS float* scr, int item, int lane) {
    const int nblk = w.Ndst / 64, kb = item / nblk, nb = item % nblk, k0 = 64 * kb, n0 = 64 * nb;
    const int nl = (lane & 15) * 4, kr = lane >> 4;
    const int s0 = colmap(w.map, n0 + nl), s1 = colmap(w.map, n0 + nl + 1), s2 = colmap(w.map, n0 + nl + 2), s3 = colmap(w.map, n0 + nl + 3);
    const bool vec = (s0 >= 0) && (s1 == s0 + 1) && (s2 == s0 + 2) && (s3 == s0 + 3);
    f32x4 v[16];
    if (vec) {
#pragma unroll
        for (int i = 0; i < 16; ++i) v[i] = *(const f32x4*)(w.src + (size_t)(k0 + 4 * i + kr) * w.Nsrc + s0);
    } else {
#pragma unroll
        for (int i = 0; i < 16; ++i) { const float* r = w.src + (size_t)(k0 + 4 * i + kr) * w.Nsrc;
            v[i] = (f32x4){s0 >= 0 ? r[s0] : 0.f, s1 >= 0 ? r[s1] : 0.f, s2 >= 0 ? r[s2] : 0.f, s3 >= 0 ? r[s3] : 0.f}; }
    }
    if (w.gain) {
#pragma unroll
        for (int i = 0; i < 16; ++i) v[i] = v[i] * w.gain[k0 + 4 * i + kr];
    }
#pragma unroll
    for (int i = 0; i < 16; ++i) { LAS float* d = scr + (4 * i + kr) * 65 + nl; d[0] = v[i][0]; d[1] = v[i][1]; d[2] = v[i][2]; d[3] = v[i][3]; }
    LDS_WAIT(); asm volatile("" ::: "memory");
    const int c = lane & 7;
#pragma unroll
    for (int j = 0; j < 8; ++j) { const int n = (lane >> 3) + 8 * j; const LAS float* sp = scr + (8 * c) * 65 + n;
        u32x4 o; o.x = cvt_pk_bf16(sp[0 * 65], sp[1 * 65]); o.y = cvt_pk_bf16(sp[2 * 65], sp[3 * 65]); o.z = cvt_pk_bf16(sp[4 * 65], sp[5 * 65]); o.w = cvt_pk_bf16(sp[6 * 65], sp[7 * 65]);
        *(u32x4*)(w.dst + (size_t)(n0 + n) * w.K + k0 + 8 * c) = o; }
    LDS_WAIT(); asm volatile("" ::: "memory");
}
__device__ __forceinline__ void prologue_phase(const Params& p, LAS unsigned char* lds, int vcu, int G, int wave, int lane) {
    LAS float* scr = (LAS float*)(lds + wave * 16640);
    const int gw = vcu * NWAVES + wave, NGW = G * NWAVES;
    int start = gw;
    for (int d = 0; d < NWDESC; ++d) { const WDesc w = wdesc(p, d); const int n = (w.K / 64) * (w.Ndst / 64);
        int it = start; for (; it < n; it += NGW) transpose_item(w, scr, it, lane);
        start = it - n; }
    bf16_t* HB = (bf16_t*)(p.ws + WS_HB); float* RSH = (float*)(p.ws + WS_RSH);
    for (int row = gw; row < S; row += NGW) { const float* xr = p.x + (size_t)row * D; float ss = 0.f;
#pragma unroll
        for (int j = 0; j < 4; ++j) { const f32x4 a = *(const f32x4*)(xr + j * 512 + lane * 8), b = *(const f32x4*)(xr + j * 512 + lane * 8 + 4);
            ss += sumsq8(a, b, 1.f); *(u32x4*)(HB + (size_t)row * D + j * 512 + lane * 8) = pack8s(a, b, 1.f); }
        ss = wave_sum(ss); if (lane == 0) RSH[row] = rsqrtf(ss * (1.0f / D) + EPS); }
    { float* RC = (float*)(p.ws + WS_RCOS); float* RS = (float*)(p.ws + WS_RSIN);
      for (int i = gw * 64 + lane; i < S * 32; i += NGW * 64) { const int row = i >> 5, k = i & 31;
          const float inv = exp2f(-(float)k * (13.287712379549449f / 32.0f)); const float ang = (float)p.pos[row] * inv;
          const float kq = rintf(ang * 0.15915494309189535f); float r = fmaf(-kq, 6.28125f, ang); r = fmaf(-kq, 1.9353071795864769e-3f, r);
          const float rev = r * 0.15915494309189535f; RC[i] = __builtin_amdgcn_cosf(rev); RS[i] = __builtin_amdgcn_sinf(rev); } }
    float* KM = (float*)(p.ws + WS_KMEAN);
    for (int i = gw * 64 + lane; i < 32 * D; i += NGW * 64) KM[i] = 0.f;
}

template <bool LAST>
__device__ __forceinline__ void resid_phase(const Params& p, const float* gain, int vcu, int G, int wave, int lane) {
    const int gw = vcu * NWAVES + wave, NGW = G * NWAVES;
    const bf16_t* MIX = (const bf16_t*)(p.ws + WS_MIX); const float* SSM = (const float*)(p.ws + WS_SSM);
    bf16_t* HB = (bf16_t*)(p.ws + WS_HB); float* RSH = (float*)(p.ws + WS_RSH);
    for (int row = gw; row < S; row += NGW) {
        float sv = (lane < 32) ? SSM[(size_t)row * 32 + lane] : 0.f; sv = wave_sum(sv);
        const float rs = rsqrtf(sv * (1.0f / D) + EPS); float ss = 0.f;
#pragma unroll
        for (int j = 0; j < 4; ++j) { const int col = j * 512 + lane * 8;
            const u32x4 mw = *(const u32x4*)(MIX + (size_t)row * D + col), hw = *(const u32x4*)(HB + (size_t)row * D + col);
            const f32x4 g0 = *(const f32x4*)(gain + col), g1 = *(const f32x4*)(gain + col + 4);
            f32x4 a, b;
            a[0] = bflo(hw.x) + bflo(mw.x) * rs * g0[0]; a[1] = bfhi(hw.x) + bfhi(mw.x) * rs * g0[1]; a[2] = bflo(hw.y) + bflo(mw.y) * rs * g0[2]; a[3] = bfhi(hw.y) + bfhi(mw.y) * rs * g0[3];
            b[0] = bflo(hw.z) + bflo(mw.z) * rs * g1[0]; b[1] = bfhi(hw.z) + bfhi(mw.z) * rs * g1[1]; b[2] = bflo(hw.w) + bflo(mw.w) * rs * g1[2]; b[3] = bfhi(hw.w) + bfhi(mw.w) * rs * g1[3];
            if (LAST) { *(f32x4*)(p.out + (size_t)row * D + col) = a; *(f32x4*)(p.out + (size_t)row * D + col + 4) = b; }
            else { *(u32x4*)(HB + (size_t)row * D + col) = pack8s(a, b, 1.f); ss += sumsq8(a, b, 1.f); } }
        if (!LAST) { ss = wave_sum(ss); if (lane == 0) RSH[row] = rsqrtf(ss * (1.0f / D) + EPS); } }
}
__device__ __forceinline__ void gate_phase(const Params& p, LAS unsigned char* lds, unsigned* cntl, int vcu, int G, int tid) {
    const bf16_t* Q = (const bf16_t*)(p.ws + WS_Q); const float* KM = (const float*)(p.ws + WS_KMEAN); const int lane = tid & 63;
    LAS float* km = (LAS float*)lds;
    for (int unit = vcu; unit < NH * 16; unit += G) {
        const int h = unit >> 4, qc = unit & 15;
        __syncthreads();
        for (int i = tid; i < 32 * 128; i += 512) km[i] = KM[(size_t)(i >> 7) * D + h * 128 + (i & 127)] * (1.0f / 256.0f);
        __syncthreads();
        const int q = qc * 512 + tid, own = q >> 8;
        float acc[32];
#pragma unroll
        for (int g = 0; g < 4; ++g) { float a8[8];
#pragma unroll
            for (int j = 0; j < 8; ++j) a8[j] = 0.f;
#pragma unroll 1
            for (int d = 0; d < 128; d += 8) { const u32x4 qw = *(const u32x4*)(Q + (size_t)q * D + h * 128 + d);
                const float q0 = bflo(qw.x), q1 = bfhi(qw.x), q2 = bflo(qw.y), q3 = bfhi(qw.y), q4 = bflo(qw.z), q5 = bfhi(qw.z), q6 = bflo(qw.w), q7 = bfhi(qw.w);
#pragma unroll
                for (int j = 0; j < 8; ++j) { const f32x4 k0 = *(const LAS f32x4*)(km + (g * 8 + j) * 128 + d), k1 = *(const LAS f32x4*)(km + (g * 8 + j) * 128 + d + 4);
                    a8[j] += (q0 * k0[0] + q1 * k0[1]) + (q2 * k0[2] + q3 * k0[3]) + (q4 * k1[0] + q5 * k1[1]) + (q6 * k1[2] + q7 * k1[3]); } }
#pragma unroll
            for (int j = 0; j < 8; ++j) acc[g * 8 + j] = a8[j]; }
        unsigned mask = 0u; const int cnt = own < 3 ? own : 3; int pk0 = -1, pk1 = -1;
#pragma unroll
        for (int k = 0; k < 3; ++k) { if (k < cnt) { float best = -__builtin_inff(); int bi = 0;
#pragma unroll
                for (int n = 0; n < 32; ++n) { const bool ok = (n < own) && !((mask >> n) & 1u) && (acc[n] > best); if (ok) { best = acc[n]; bi = n; } }
                mask |= 1u << bi; if (k == 0) pk0 = bi; if (k == 1) pk1 = bi; } }
        unsigned* cnt_h = cntl + h * 32; unsigned short* LIST = (unsigned short*)(p.ws + WS_LIST) + ((size_t)h * 32 << 13);
        const int own_w = __builtin_amdgcn_readfirstlane(own);
        for (int n = 0; n < own_w; ++n) { const bool sel = ((mask >> n) & 1u) != 0u; const unsigned long long bal = __ballot(sel);
            if (bal != 0ull) { const int first = (int)__builtin_ctzll(bal); unsigned base = 0u;
                if (lane == first) base = __hip_atomic_fetch_add(cnt_h + n, (unsigned)__popcll(bal), __ATOMIC_RELAXED, __HIP_MEMORY_SCOPE_AGENT);
                base = (unsigned)__builtin_amdgcn_readlane((int)base, first);
                if (sel) { const unsigned pos_ = base + (unsigned)__popcll(bal & ((1ull << lane) - 1ull)); const unsigned slot = (n == pk0) ? 0u : (n == pk1 ? 1u : 2u);
                    LIST[((size_t)n << 13) + pos_] = (unsigned short)((unsigned)q | (slot << 13)); } } }
    }
}

__device__ __forceinline__ void moba_combine_phase(const Params& p, int vcu, int G, int wave, int lane) {
    constexpr float C2 = 1.4426950408889634f * 0.08838834764831845f;
    const int gw = vcu * NWAVES + wave, NGW = G * NWAVES; const int h = lane >> 2, part = lane & 3;
    const bf16_t* OP = (const bf16_t*)(p.ws + WS_OP); const float* MLP = (const float*)(p.ws + WS_MLP); bf16_t* O = (bf16_t*)(p.ws + WS_O);
    for (int q = gw; q < S; q += NGW) { const int own = q >> 8, nsel = own < 3 ? own : 3;
        float m[4], l[4]; float ms = -1e30f;
#pragma unroll
        for (int sl = 0; sl < 4; ++sl) { const bool ok = (sl == 3) || (sl < nsel); m[sl] = -1e30f; l[sl] = 0.f;
            if (ok) { const f32x2 ml = *(const f32x2*)(MLP + 2 * ((size_t)(sl * S + q) * NH + h)); m[sl] = ml[0]; l[sl] = ml[1]; ms = fmaxf(ms, ml[0]); } }
        float acc[32];
#pragma unroll
        for (int i = 0; i < 32; ++i) acc[i] = 0.f;
        float wsum = 0.f;
#pragma unroll
        for (int sl = 0; sl < 4; ++sl) { const bool ok = (sl == 3) || (sl < nsel);
            if (ok) { const float w = l[sl] * __builtin_amdgcn_exp2f((m[sl] - ms) * C2); wsum += w; const bf16_t* src = OP + ((size_t)(sl * S + q) * NH + h) * 128 + part * 32;
#pragma unroll
                for (int c4 = 0; c4 < 4; ++c4) { const u32x4 v = *(const u32x4*)(src + c4 * 8);
                    acc[c4 * 8 + 0] += w * bflo(v.x); acc[c4 * 8 + 1] += w * bfhi(v.x); acc[c4 * 8 + 2] += w * bflo(v.y); acc[c4 * 8 + 3] += w * bfhi(v.y);
                    acc[c4 * 8 + 4] += w * bflo(v.z); acc[c4 * 8 + 5] += w * bfhi(v.z); acc[c4 * 8 + 6] += w * bflo(v.w); acc[c4 * 8 + 7] += w * bfhi(v.w); } } }
        const float rw = 1.0f / wsum; bf16_t* dst = O + (size_t)q * D + h * 128 + part * 32;
#pragma unroll
        for (int c4 = 0; c4 < 4; ++c4) { u32x4 w; w.x = cvt_pk_bf16(acc[c4 * 8 + 0] * rw, acc[c4 * 8 + 1] * rw); w.y = cvt_pk_bf16(acc[c4 * 8 + 2] * rw, acc[c4 * 8 + 3] * rw);
            w.z = cvt_pk_bf16(acc[c4 * 8 + 4] * rw, acc[c4 * 8 + 5] * rw); w.w = cvt_pk_bf16(acc[c4 * 8 + 6] * rw, acc[c4 * 8 + 7] * rw); *(u32x4*)(dst + c4 * 8) = w; } }
}

__global__ void __launch_bounds__(NWAVES * 64, 2) fwd_kernel(Params p) {
    extern __shared__ __attribute__((aligned(16))) unsigned char lds_raw[];
    LAS unsigned char* lds = (LAS unsigned char*)lds_raw;
    const int tid = threadIdx.x, lane = tid & 63, wave = __builtin_amdgcn_readfirstlane(tid >> 6);
    const int G = gridDim.x; const int bx = blockIdx.x; const int vcu = (G % 8 == 0) ? (bx % 8) * (G / 8) + bx / 8 : bx;
    volatile LAS unsigned* MISC = (volatile LAS unsigned*)(lds + MISC_OFF);
    for (int u = tid; u < (LDS_BYTES - LDSCTL_OFF) / 4; u += NWAVES * 64) ((LAS unsigned*)(lds + LDSCTL_OFF))[u] = 0u;
    __syncthreads();
    unsigned* ctl = (unsigned*)(p.ws + WS_CTL);
    XcdBarrier bar; bar.bar = ctl + CW_BAR; bar.x = 0; bar.st = nullptr;
    const bool one_launch = (p.ph_hi - p.ph_lo) > 1;
    if (one_launch) bar = xcd_barrier_post(ctl + CW_BAR, MISC + 8);
    const int lo = p.ph_lo, hi = p.ph_hi;
    int ph = 0;
#define IN() (lo <= ph && ph < hi)
#define SEAM() do { if (ph + 1 < hi) xcd_barrier(bar); } while (0)

    bf16_t* HB = (bf16_t*)(p.ws + WS_HB); float* RSH = (float*)(p.ws + WS_RSH);
    bf16_t* CQ = (bf16_t*)(p.ws + WS_CQ); bf16_t* CKV = (bf16_t*)(p.ws + WS_CKV); bf16_t* KROPE = (bf16_t*)(p.ws + WS_KROPE); float* SSQ = (float*)(p.ws + WS_SSQ);
    bf16_t* Qb = (bf16_t*)(p.ws + WS_Q); bf16_t* KN = (bf16_t*)(p.ws + WS_KN); bf16_t* Vb = (bf16_t*)(p.ws + WS_V);
    bf16_t* KB = (bf16_t*)(p.ws + WS_KB); bf16_t* VB = (bf16_t*)(p.ws + WS_VB); float* KMEAN = (float*)(p.ws + WS_KMEAN);
    bf16_t* Ob = (bf16_t*)(p.ws + WS_O); bf16_t* MIX = (bf16_t*)(p.ws + WS_MIX); float* SSM = (float*)(p.ws + WS_SSM);
    bf16_t* Ub = (bf16_t*)(p.ws + WS_U); bf16_t* ACT = (bf16_t*)(p.ws + WS_ACT);
    const float* RCOS = (const float*)(p.ws + WS_RCOS); const float* RSIN = (const float*)(p.ws + WS_RSIN);

    if (SITE(0) && IN()) { REPS(0) { { const int t_ = opaque_tid(); prologue_phase(p, lds, vcu, G, __builtin_amdgcn_readfirstlane(t_ >> 6), t_ & 63); } } SEAM(); } ++ph;

    for (int layer = 0; layer < NLAYER; ++layer) {
        if (layer < 2) {
            if (SITE(1) && IN()) { REPS(1) { pg8::Sched Sc; Sc.init(S, D, HB, (const bf16_t*)(p.ws + WS_WIN) + (size_t)layer * NINP * D, NINP, nullptr, nullptr, 0, G, bx);
                EpiMlaIn E{CQ, CKV, KROPE, SSQ, RSH, RCOS, RSIN};
                pg8::gemm_phase<EpiMlaIn, true, true>(lds, D, Sc, E); } SEAM(); } ++ph;
            if (SITE(2) && IN()) { REPS(2) { const bf16_t* W = (const bf16_t*)(p.ws + WS_WUPG) + (size_t)layer * 7168 * 512;
                pg8::Sched Sc; Sc.init(S, 512, CQ, W, NQUP, CKV, W + (size_t)NQUP * 512, NKVUP, G, bx);
                EpiMlaUp E{Qb, KN, Vb, SSQ, RCOS, RSIN};
                pg8::gemm_phase<EpiMlaUp, true, true>(lds, 512, Sc, E); } SEAM(); } ++ph;
            if (SITE(3) && IN()) { REPS(3) { att::Args T{Qb, KN, KROPE, Vb, Ob, nullptr, nullptr, p.pos};
                for (int it = vcu; it < NH * 16; it += G) { const int h = it >> 4, y = it & 15;
                    att::attn_unit<false>(lds, T, h, y); att::attn_unit<false>(lds, T, h, 31 - y); }
                } SEAM(); } ++ph;
        } else {
            if (SITE(4) && IN()) { REPS(4) { const bool first = (layer == 2);
                pg8::Sched Sc; Sc.init(S, D, HB, first ? (const bf16_t*)(p.ws + WS_WKVQ) : (const bf16_t*)(p.ws + WS_WQ1), first ? 6144 : 2048, nullptr, nullptr, 0, G, bx);
                EpiMobaKvq E{p.ws, KMEAN, RSH, first ? 0 : 16};
                pg8::gemm_phase<EpiMobaKvq, true, true>(lds, D, Sc, E); } SEAM(); } ++ph;
            if (SITE(5) && IN()) { REPS(5) { gate_phase(p, lds, ctl + CW_CNT + (layer - 2) * 512, vcu, G, opaque_tid()); } SEAM(); } ++ph;
            if (SITE(6) && IN()) { REPS(6) { att::MobaArgs T{Qb, KB, VB, (const unsigned short*)(p.ws + WS_LIST), (bf16_t*)(p.ws + WS_OP), (float*)(p.ws + WS_MLP), p.rel_bias, p.pos};
                att::moba_phase(lds, T, ctl + CW_CNT + (layer - 2) * 512, vcu, G); } SEAM(); } ++ph;
            if (SITE(13) && IN()) { REPS(13) { const int t_ = opaque_tid(); moba_combine_phase(p, vcu, G, __builtin_amdgcn_readfirstlane(t_ >> 6), t_ & 63); } SEAM(); } ++ph;
        }
        if (SITE(7) && IN()) { REPS(7) { pg8::Sched Sc; Sc.init(S, D, Ob, (const bf16_t*)(p.ws + WS_WO) + (size_t)layer * D * D, D, nullptr, nullptr, 0, G, bx);
            EpiMix E{MIX, SSM};
            pg8::gemm_phase<EpiMix, false, true>(lds, D, Sc, E); } SEAM(); } ++ph;
        if (SITE(8) && IN()) { REPS(8) { { const int t_ = opaque_tid(); resid_phase<false>(p, p.gains + (size_t)(layer * 4 + 1) * D, vcu, G, __builtin_amdgcn_readfirstlane(t_ >> 6), t_ & 63); } } SEAM(); } ++ph;
        if (SITE(9) && IN()) { REPS(9) { pg8::Sched Sc; Sc.init(S, D, HB, (const bf16_t*)(p.ws + WS_WUP) + (size_t)layer * FF2 * D, FF2, nullptr, nullptr, 0, G, bx, 254, -2);
            EpiFfnUpConv E{ACT, RSH, p.ffn_conv_w + (size_t)layer * 3 * FF2, p.ffn_conv_b + (size_t)layer * FF2, lds + RING_BYTES};
            pg8::gemm_phase<EpiFfnUpConv, true, true, true>(lds, D, Sc, E); } SEAM(); } ++ph;
        if (SITE(11) && IN()) { REPS(11) { pg8::Sched Sc; Sc.init(S, FF, ACT, (const bf16_t*)(p.ws + WS_WDN) + (size_t)layer * D * FF, D, nullptr, nullptr, 0, G, bx);
            EpiMix E{MIX, SSM};
            pg8::gemm_phase<EpiMix, false, true>(lds, FF, Sc, E); } SEAM(); } ++ph;
        if (SITE(12) && IN()) { REPS(12) { { const int t_ = opaque_tid(); if (layer == NLAYER - 1) resid_phase<true>(p, p.gains + (size_t)(layer * 4 + 3) * D, vcu, G, __builtin_amdgcn_readfirstlane(t_ >> 6), t_ & 63); else resid_phase<false>(p, p.gains + (size_t)(layer * 4 + 3) * D, vcu, G, __builtin_amdgcn_readfirstlane(t_ >> 6), t_ & 63); } } SEAM(); } ++ph;
    }
#undef IN
#undef SEAM
}

extern "C" void kernel_launch(void* const* d_in, const int* in_sizes, int n_in, void* d_out, int out_size, void* d_ws, size_t ws_size, hipStream_t stream) {
    static int grid = 0;
    if (grid == 0) {
        if (n_in != 18 || in_sizes[0] != S * D || out_size != S * D || ws_size < WS_END) { fprintf(stderr, "kernel_launch: unexpected shapes (n_in %d, in0 %d, out %d, ws %zu)\n", n_in, n_in > 0 ? in_sizes[0] : -1, out_size, ws_size); grid = -1; return; }
        int dev = 0, cus = 0, per_cu = 0;
        if (hipGetDevice(&dev) != hipSuccess || hipDeviceGetAttribute(&cus, hipDeviceAttributeMultiprocessorCount, dev) != hipSuccess) { grid = -1; return; }
        if (hipFuncSetAttribute((const void*)fwd_kernel, hipFuncAttributeMaxDynamicSharedMemorySize, LDS_BYTES) != hipSuccess) { fprintf(stderr, "kernel_launch: hipFuncSetAttribute failed\n"); grid = -1; return; }
        if (hipOccupancyMaxActiveBlocksPerMultiprocessor(&per_cu, (const void*)fwd_kernel, NWAVES * 64, LDS_BYTES) != hipSuccess || per_cu < 1) fprintf(stderr, "kernel_launch: occupancy query reports %d\n", per_cu);
        (void)hipGetLastError();
        grid = cus;
    }
    if (grid < 0) return;
    (void)hipMemsetAsync((char*)d_ws + WS_CTL, 0, CTL_ZERO_BYTES, stream);
    Params p{};
    p.x = (const float*)d_in[0]; p.pos = (const int*)d_in[1]; p.gains = (const float*)d_in[2]; p.a_w_in = (const float*)d_in[3]; p.a_q_norm = (const float*)d_in[4];
    p.a_w_q_up = (const float*)d_in[5]; p.a_kv_norm = (const float*)d_in[6]; p.a_w_kv_up = (const float*)d_in[7]; p.a_w_o = (const float*)d_in[8]; p.b_kv_norm = (const float*)d_in[9];
    p.b_w_kv = (const float*)d_in[10]; p.b_w_q = (const float*)d_in[11]; p.b_w_o = (const float*)d_in[12]; p.rel_bias = (const float*)d_in[13]; p.ffn_w_in = (const float*)d_in[14];
    p.ffn_conv_w = (const float*)d_in[15]; p.ffn_conv_b = (const float*)d_in[16]; p.ffn_w_out = (const float*)d_in[17]; p.out = (float*)d_out; p.ws = (unsigned char*)d_ws;
#if MK_ONE_LAUNCH
    p.ph_lo = 0; p.ph_hi = NPHASE;
    hipLaunchKernelGGL(fwd_kernel, dim3(grid), dim3(NWAVES * 64), LDS_BYTES, stream, p);
#else
    for (int ph = 0; ph < NPHASE; ++ph) { p.ph_lo = ph; p.ph_hi = ph + 1;
        hipLaunchKernelGGL(fwd_kernel, dim3(grid), dim3(NWAVES * 64), LDS_BYTES, stream, p); }
#endif
}
```
